# Optimizing an MI355X kernel written in HIP

```python
import math
import jax, jax.numpy as jnp
from jax import lax
import numpy as np

D_MODEL = 1024
BATCH = 2
SEQ = 8192
DEPTH = 2

GRID_W = 64
CTX_LEN = 256
HEAD_DIM = 64
GQA_HEADS = 8
GQA_KV_HEADS = 2
GQA_GROUP = GQA_HEADS // GQA_KV_HEADS
NA_HEADS = 8
NA_KH = 8
NA_KW = 16
MLA_HEADS = 8
MLA_NOPE = 64
MLA_ROPE = 32
MLA_V = 64
MLA_KV_RANK = 256
N_BRANCH = 3
D_FF = 4 * D_MODEL
Q_BLOCK = 128
ROPE_THETA = 10000.0
EPS = 1e-6
IN_SIZES = (
    GQA_HEADS * HEAD_DIM,
    GQA_KV_HEADS * HEAD_DIM,
    GQA_KV_HEADS * HEAD_DIM,
    NA_HEADS * HEAD_DIM,
    NA_HEADS * HEAD_DIM,
    NA_HEADS * HEAD_DIM,
    MLA_HEADS * (MLA_NOPE + MLA_ROPE),
    MLA_KV_RANK,
    MLA_ROPE,
    N_BRANCH * D_MODEL,
)
W_IN_COLS = sum(IN_SIZES)

kernel_name = 'hybrid_gqa_natten_mla_dit_block'


def rmsnorm(x, g):
    xf = x.astype(jnp.float32)
    y = xf * lax.rsqrt(jnp.mean(xf * xf, axis=-1, keepdims=True) + EPS)
    return (y * g.astype(jnp.float32)).astype(x.dtype)


def modulate(h, shift, scale):
    return h * (1 + scale) + shift


def split_cols(p):
    pts = []
    acc = 0
    for sz in IN_SIZES[:-1]:
        acc += sz
        pts.append(acc)
    return jnp.split(p, pts, axis=-1)


def axial_angles(n_tokens, rot_dim):
    t = jnp.arange(n_tokens, dtype=jnp.int32)
    row = (t // GRID_W).astype(jnp.float32)
    col = (t % GRID_W).astype(jnp.float32)
    half = rot_dim // 2
    inv_freq = ROPE_THETA ** (-jnp.arange(0, half, 2, dtype=jnp.float32) / half)
    return row[:, None] * inv_freq, col[:, None] * inv_freq


def rope_1d(x, ang):
    cos = jnp.cos(ang)[:, None, :].astype(x.dtype)
    sin = jnp.sin(ang)[:, None, :].astype(x.dtype)
    x1, x2 = jnp.split(x, 2, axis=-1)
    return jnp.concatenate([x1 * cos - x2 * sin, x2 * cos + x1 * sin], axis=-1)


def rope_axial(x, angles):
    ang_row, ang_col = angles
    xr, xc = jnp.split(x, 2, axis=-1)
    return jnp.concatenate([rope_1d(xr, ang_row), rope_1d(xc, ang_col)], axis=-1)


def sdpa_blocks(q, k, v, scale):
    b, s = q.shape[:2]
    nb = s // Q_BLOCK
    qb = jnp.swapaxes(q.reshape((b, nb, Q_BLOCK) + q.shape[2:]), 0, 1)

    def one(qblk):
        sc = jnp.einsum('bqkgd,btkd->bkgqt', qblk, k).astype(jnp.float32) * scale
        p = jax.nn.softmax(sc, axis=-1).astype(v.dtype)
        return jnp.einsum('bkgqt,btke->bqkge', p, v)

    o = lax.map(one, qb)
    return jnp.swapaxes(o, 0, 1).reshape(b, s, q.shape[2] * q.shape[3] * v.shape[-1])


def neighbourhood_attention(q, k, v, k_ctx, v_ctx, rpb):
    b, s, h, d = q.shape
    rows = s // GRID_W
    kh = min(NA_KH, rows)
    kw = NA_KW
    scale = d ** -0.5
    qg = q.reshape(b, rows, GRID_W, h, d)
    kg = k.reshape(b, rows, GRID_W, h, d)
    vg = v.reshape(b, rows, GRID_W, h, d)
    cols = jnp.arange(GRID_W, dtype=jnp.int32)
    col_start = jnp.clip(cols - kw // 2, 0, GRID_W - kw)
    col_idx = col_start[:, None] + jnp.arange(kw, dtype=jnp.int32)[None, :]
    col_bias_idx = col_idx - cols[:, None] + (NA_KW - 1)
    n_win = kh * kw

    def one(args):
        r, q_row = args
        rs = jnp.clip(r - kh // 2, 0, rows - kh)
        k_rows = lax.dynamic_slice_in_dim(kg, rs, kh, axis=1)
        v_rows = lax.dynamic_slice_in_dim(vg, rs, kh, axis=1)
        k_win = k_rows[:, :, col_idx]
        v_win = v_rows[:, :, col_idx]
        row_bias_idx = rs + jnp.arange(kh, dtype=jnp.int32) - r + (NA_KH - 1)
        bias = rpb[:, row_bias_idx][:, :, col_bias_idx]
        bias = jnp.transpose(bias, (0, 2, 1, 3))[None].astype(jnp.float32)
        s_win = jnp.einsum('bqhd,biqjhd->bhqij', q_row, k_win).astype(jnp.float32) * scale + bias
        s_ctx = jnp.einsum('bqhd,bthd->bhqt', q_row, k_ctx).astype(jnp.float32) * scale
        sc = jnp.concatenate([s_win.reshape(b, h, GRID_W, n_win), s_ctx], axis=-1)
        p = jax.nn.softmax(sc, axis=-1).astype(v.dtype)
        p_win = p[..., :n_win].reshape(b, h, GRID_W, kh, kw)
        p_ctx = p[..., n_win:]
        return (jnp.einsum('bhqij,biqjhd->bqhd', p_win, v_win)
                + jnp.einsum('bhqt,bthd->bqhd', p_ctx, v_ctx))

    o = lax.map(one, (jnp.arange(rows, dtype=jnp.int32), jnp.swapaxes(qg, 0, 1)))
    return jnp.swapaxes(o, 0, 1).reshape(b, s, h * d)


def project(h, w_in, q_norm, k_norm, kv_norm, w_uk, w_uv, ang_a, ang_m):
    b, n, _ = h.shape
    (ga_q, ga_k, ga_v, na_q, na_k, na_v, ml_q, ml_ckv, ml_kr, gates) = split_cols(h @ w_in)
    ga_q = rmsnorm(ga_q.reshape(b, n, GQA_HEADS, HEAD_DIM), q_norm)
    ga_k = rmsnorm(ga_k.reshape(b, n, GQA_KV_HEADS, HEAD_DIM), k_norm)
    ga_v = ga_v.reshape(b, n, GQA_KV_HEADS, HEAD_DIM)
    na_q = na_q.reshape(b, n, NA_HEADS, HEAD_DIM)
    na_k = na_k.reshape(b, n, NA_HEADS, HEAD_DIM)
    na_v = na_v.reshape(b, n, NA_HEADS, HEAD_DIM)
    ml_q = ml_q.reshape(b, n, MLA_HEADS, MLA_NOPE + MLA_ROPE)
    q_nope, q_rope = ml_q[..., :MLA_NOPE], ml_q[..., MLA_NOPE:]
    c_kv = rmsnorm(ml_ckv, kv_norm)
    k_nope = (c_kv @ w_uk).reshape(b, n, MLA_HEADS, MLA_NOPE)
    ml_v = (c_kv @ w_uv).reshape(b, n, MLA_HEADS, MLA_V)
    k_rope = ml_kr[:, :, None, :]
    if ang_a is not None:
        ga_q = rope_axial(ga_q, ang_a)
        ga_k = rope_axial(ga_k, ang_a)
        q_rope = rope_axial(q_rope, ang_m)
        k_rope = rope_axial(k_rope, ang_m)
    ml_q = jnp.concatenate([q_nope, q_rope], axis=-1)
    ml_k = jnp.concatenate([k_nope, jnp.broadcast_to(k_rope, (b, n, MLA_HEADS, MLA_ROPE))], axis=-1)
    gates = jax.nn.sigmoid(gates.astype(jnp.float32)).astype(h.dtype).reshape(b, n, N_BRANCH, D_MODEL)
    return {'ga_q': ga_q, 'ga_k': ga_k, 'ga_v': ga_v, 'na_q': na_q, 'na_k': na_k, 'na_v': na_v,
            'ml_q': ml_q, 'ml_k': ml_k, 'ml_v': ml_v, 'gates': gates}


def merge(ya, yb, yc, gates, w_o_gqa, w_o_na, w_o_mla, w_out):
    y = (gates[..., 0, :] * (ya @ w_o_gqa)
         + gates[..., 1, :] * (yb @ w_o_na)
         + gates[..., 2, :] * (yc @ w_o_mla))
    return y @ w_out


def parallel_mixer(h_lat, h_ctx, w_in, q_norm, k_norm, rpb, kv_norm, w_uk, w_uv,
                   w_o_gqa, w_o_na, w_o_mla, w_out, ang_a, ang_m, with_ctx):
    b, s, _ = h_lat.shape
    pl = project(h_lat, w_in, q_norm, k_norm, kv_norm, w_uk, w_uv, ang_a, ang_m)
    pc = project(h_ctx, w_in, q_norm, k_norm, kv_norm, w_uk, w_uv, None, None)
    sc_a = HEAD_DIM ** -0.5
    sc_m = (MLA_NOPE + MLA_ROPE) ** -0.5
    k_all = jnp.concatenate([pl['ga_k'], pc['ga_k']], axis=1)
    v_all = jnp.concatenate([pl['ga_v'], pc['ga_v']], axis=1)
    ya = sdpa_blocks(pl['ga_q'].reshape(b, s, GQA_KV_HEADS, GQA_GROUP, HEAD_DIM), k_all, v_all, sc_a)
    yb = neighbourhood_attention(pl['na_q'], pl['na_k'], pl['na_v'], pc['na_k'], pc['na_v'], rpb)
    mk_all = jnp.concatenate([pl['ml_k'], pc['ml_k']], axis=1)
    mv_all = jnp.concatenate([pl['ml_v'], pc['ml_v']], axis=1)
    yc = sdpa_blocks(pl['ml_q'][:, :, :, None, :], mk_all, mv_all, sc_m)
    out_lat = merge(ya, yb, yc, pl['gates'], w_o_gqa, w_o_na, w_o_mla, w_out)
    if not with_ctx:
        return out_lat, None
    bc, cl, _ = h_ctx.shape
    ca = sdpa_blocks(pc['ga_q'].reshape(bc, cl, GQA_KV_HEADS, GQA_GROUP, HEAD_DIM), pc['ga_k'], pc['ga_v'], sc_a)
    cb = sdpa_blocks(pc['na_q'][:, :, :, None, :], pc['na_k'], pc['na_v'], sc_a)
    cc = sdpa_blocks(pc['ml_q'][:, :, :, None, :], pc['ml_k'], pc['ml_v'], sc_m)
    out_ctx = merge(ca, cb, cc, pc['gates'], w_o_gqa, w_o_na, w_o_mla, w_out)
    return out_lat, out_ctx


def sq_relu_mlp(h, w1, w2):
    return jnp.square(jax.nn.relu(h @ w1)) @ w2


def setup_inputs(seed: int = 0) -> dict:
    key = jax.random.key(seed)
    ks = jax.random.split(key, 24)
    d = D_MODEL

    def nrm(k, shape, scale):
        return jax.random.normal(k, shape, jnp.float32) * scale

    def gain(k, shape):
        return 1.0 + 0.01 * jax.random.normal(k, shape, jnp.float32)

    return {
        'x': nrm(ks[0], (BATCH, SEQ, d), 1.0),
        'c': nrm(ks[1], (BATCH, d), 1.0),
        'ctx': nrm(ks[2], (BATCH, CTX_LEN, d), 1.0),
        'c_ctx': nrm(ks[3], (d,), 1.0),
        'w_mod': nrm(ks[4], (DEPTH, d, 6 * d), 0.5 * d ** -0.5),
        'b_mod': nrm(ks[5], (DEPTH, 6 * d), 0.02),
        'norm1_g': gain(ks[6], (DEPTH, d)),
        'norm2_g': gain(ks[7], (DEPTH, d)),
        'w_in': nrm(ks[8], (DEPTH, d, W_IN_COLS), d ** -0.5),
        'gqa_q_norm': gain(ks[9], (DEPTH, HEAD_DIM)),
        'gqa_k_norm': gain(ks[10], (DEPTH, HEAD_DIM)),
        'na_rpb': nrm(ks[11], (DEPTH, NA_HEADS, 2 * NA_KH - 1, 2 * NA_KW - 1), 0.1),
        'mla_kv_norm': gain(ks[12], (DEPTH, MLA_KV_RANK)),
        'mla_w_uk': nrm(ks[13], (DEPTH, MLA_KV_RANK, MLA_HEADS * MLA_NOPE), MLA_KV_RANK ** -0.5),
        'mla_w_uv': nrm(ks[14], (DEPTH, MLA_KV_RANK, MLA_HEADS * MLA_V), MLA_KV_RANK ** -0.5),
        'w_o_gqa': nrm(ks[15], (DEPTH, GQA_HEADS * HEAD_DIM, d), (GQA_HEADS * HEAD_DIM) ** -0.5),
        'w_o_na': nrm(ks[16], (DEPTH, NA_HEADS * HEAD_DIM, d), (NA_HEADS * HEAD_DIM) ** -0.5),
        'w_o_mla': nrm(ks[17], (DEPTH, MLA_HEADS * MLA_V, d), (MLA_HEADS * MLA_V) ** -0.5),
        'w_out': nrm(ks[18], (DEPTH, d, d), d ** -0.5),
        'w_mlp1': nrm(ks[19], (DEPTH, d, D_FF), d ** -0.5),
        'w_mlp2': nrm(ks[20], (DEPTH, D_FF, d), D_FF ** -0.5),
        'final_norm_g': gain(ks[21], (d,)),
    }


def reference(x, c, ctx, c_ctx, w_mod, b_mod, norm1_g, norm2_g, w_in, gqa_q_norm, gqa_k_norm,
              na_rpb, mla_kv_norm, mla_w_uk, mla_w_uv, w_o_gqa, w_o_na, w_o_mla, w_out,
              w_mlp1, w_mlp2, final_norm_g):
    s = x.shape[1]
    ang_a = axial_angles(s, HEAD_DIM)
    ang_m = axial_angles(s, MLA_ROPE)
    cond_lat = jax.nn.silu(c)
    cond_ctx = jax.nn.silu(c_ctx)[None, :]
    for l in range(DEPTH):
        with_ctx = l < DEPTH - 1
        m_lat = (cond_lat @ w_mod[l] + b_mod[l])[:, None, :]
        m_ctx = (cond_ctx @ w_mod[l] + b_mod[l])[:, None, :]
        sh1, sc1, g1, sh2, sc2, g2 = jnp.split(m_lat, 6, axis=-1)
        csh1, csc1, cg1, csh2, csc2, cg2 = jnp.split(m_ctx, 6, axis=-1)
        h_lat = modulate(rmsnorm(x, norm1_g[l]), sh1, sc1)
        h_ctx = modulate(rmsnorm(ctx, norm1_g[l]), csh1, csc1)
        a_lat, a_ctx = parallel_mixer(h_lat, h_ctx, w_in[l], gqa_q_norm[l], gqa_k_norm[l], na_rpb[l],
                                      mla_kv_norm[l], mla_w_uk[l], mla_w_uv[l], w_o_gqa[l], w_o_na[l],
                                      w_o_mla[l], w_out[l], ang_a, ang_m, with_ctx)
        x = x + g1 * a_lat
        x = x + g2 * sq_relu_mlp(modulate(rmsnorm(x, norm2_g[l]), sh2, sc2), w_mlp1[l], w_mlp2[l])
        if with_ctx:
            ctx = ctx + cg1 * a_ctx
            ctx = ctx + cg2 * sq_relu_mlp(modulate(rmsnorm(ctx, norm2_g[l]), csh2, csc2), w_mlp1[l], w_mlp2[l])
    return rmsnorm(x, final_norm_g)
```

```cpp
#include <hip/hip_runtime.h>
#include <hip/hip_cooperative_groups.h>
#include <cstdio>
#include <cstdint>
namespace cg = cooperative_groups;

#ifndef DUPMASK
#define DUPMASK 0
#endif
#ifndef N_LAUNCH_MODE
#define N_LAUNCH_MODE 1
#endif

#define LAS __attribute__((address_space(3)))
#define GAS __attribute__((address_space(1)))
typedef unsigned short bf16_t;
typedef short bf16x8 __attribute__((ext_vector_type(8)));
typedef short s16x4 __attribute__((ext_vector_type(4)));
typedef float f32x2 __attribute__((ext_vector_type(2)));
typedef float f32x4 __attribute__((ext_vector_type(4)));
typedef float f32x16 __attribute__((ext_vector_type(16)));
typedef unsigned u32x2 __attribute__((ext_vector_type(2)));
typedef unsigned u32x4 __attribute__((ext_vector_type(4)));
typedef __bf16 bf16x2_t __attribute__((ext_vector_type(2)));

constexpr int DM = 1024, SEQ = 8192, NLAT = 16384, CTXL = 256, NCTX = 512, MP = 16896, DFF = 4096;
constexpr int WIN_COLS = 6432;
constexpr int PQ_LD = 2304, PKV_LD = 1792, GATE_LD = 3072;
constexpr float EPS = 1e-6f;
constexpr float LOG2E = 1.4426950408889634f;
constexpr int NPH = 24;

constexpr size_t KiB = 1024, MiB = 1u << 20;
constexpr size_t WS_MOD = 0;
constexpr size_t WS_BAR = 512 * KiB;
constexpr size_t WS_TABA = 1 * MiB;
constexpr size_t WS_TABM = 3 * MiB;
constexpr size_t WS_XC = 4 * MiB;
constexpr size_t WS_W1T = 6 * MiB, WS_W2T = 14 * MiB, WS_WINT = 22 * MiB, WS_WUKVT = 35 * MiB, WS_WO3T = 35 * MiB + 512 * KiB, WS_WOUTT = 38 * MiB + 512 * KiB;
constexpr size_t WS_H = 40 * MiB + 512 * KiB;
constexpr size_t WS_PQ = WS_H + (size_t)MP * 1024 * 2;
constexpr size_t WS_PKV = WS_PQ + (size_t)MP * PQ_LD * 2;
constexpr size_t WS_CKV = WS_PKV + (size_t)MP * PKV_LD * 2;
constexpr size_t WS_MLAKN = WS_CKV + (size_t)MP * 256 * 2;
constexpr size_t WS_MLAV = WS_MLAKN + (size_t)MP * 512 * 2;
constexpr size_t WS_KR = WS_MLAV + (size_t)MP * 512 * 2;
constexpr size_t WS_END = WS_KR + (size_t)MP * 32 * 2;
constexpr size_t WS_GATES = WS_PKV;
constexpr size_t WS_HID = WS_PQ;
static_assert(WS_GATES + (size_t)MP * GATE_LD * 2 <= WS_KR, "gates overlay");
static_assert(WS_HID + (size_t)MP * DFF * 2 <= WS_END, "hid overlay");
static_assert(WS_END <= 256 * MiB, "workspace");

constexpr int LDS_BYTES = 147456;

__device__ __forceinline__ float bf2f(bf16_t v) { return __uint_as_float(((unsigned)v) << 16); }
__device__ __forceinline__ float bflo(unsigned w) { return __uint_as_float(w << 16); }
__device__ __forceinline__ float bfhi(unsigned w) { return __uint_as_float(w & 0xffff0000u); }
__device__ __forceinline__ unsigned pk2(float lo, float hi) { f32x2 v = {lo, hi}; bf16x2_t b = __builtin_convertvector(v, bf16x2_t); return __builtin_bit_cast(unsigned, b); }
__device__ __forceinline__ bf16_t f2bf(float f) { return (bf16_t)(pk2(f, 0.f) & 0xffffu); }
__device__ __forceinline__ float wave_sum(float v) {
    v += __int_as_float(__builtin_amdgcn_update_dpp(0, __float_as_int(v), 0xB1, 0xf, 0xf, true));
    v += __int_as_float(__builtin_amdgcn_update_dpp(0, __float_as_int(v), 0x4E, 0xf, 0xf, true));
    v += __int_as_float(__builtin_amdgcn_update_dpp(0, __float_as_int(v), 0x141, 0xf, 0xf, true));
    v += __int_as_float(__builtin_amdgcn_update_dpp(0, __float_as_int(v), 0x140, 0xf, 0xf, true));
    const float s0 = __int_as_float(__builtin_amdgcn_readlane(__float_as_int(v), 0)), s1 = __int_as_float(__builtin_amdgcn_readlane(__float_as_int(v), 16));
    const float s2 = __int_as_float(__builtin_amdgcn_readlane(__float_as_int(v), 32)), s3 = __int_as_float(__builtin_amdgcn_readlane(__float_as_int(v), 48));
    return (s0 + s1) + (s2 + s3);
}
__device__ __forceinline__ float swap_max(float m) { auto rr = __builtin_amdgcn_permlane32_swap(__float_as_uint(m), __float_as_uint(m), false, false); return fmaxf(__uint_as_float(rr[0]), __uint_as_float(rr[1])); }
__device__ __forceinline__ float swap_sum(float m) { auto rr = __builtin_amdgcn_permlane32_swap(__float_as_uint(m), __float_as_uint(m), false, false); return __uint_as_float(rr[0]) + __uint_as_float(rr[1]); }
__device__ __forceinline__ float fast_sigmoid(float x) { return fmaxf(__builtin_amdgcn_rcpf(1.f + __builtin_amdgcn_exp2f(-x * LOG2E)), 1e-30f); }

namespace pg8 {
constexpr int BM = 256, BK = 64, HALF = 128, HTB = HALF * BK * 2, STAGE_BYTES = 8 * HTB, NXCD = 8, WGM = 8;
__device__ __forceinline__ int lds_byte(int r, int c) { const int st = (r >> 4) * 2 + (c >> 5), rr = r & 15, cc = c & 31, ob = rr * 64 + cc * 2; return st * 1024 + (ob ^ (((ob >> 9) & 1) << 5)); }
__device__ __forceinline__ void stage_rc(int b, int& R, int& C) { const int st = b / 1024, sb = b % 1024, swz = sb ^ (((sb >> 9) & 1) << 5); R = (st >> 1) * 16 + swz / 64; C = (st & 1) * 32 + (swz % 64) / 2; }
__device__ __forceinline__ int perm32(int rho) { const int n = rho >> 4, i = rho & 15; return 8 * (i >> 2) + 4 * n + (i & 3); }

struct Unit { const char* a; const char* b; int nt; int kind; int pm; int pn; };

template <class Epi, class Sched>
__device__ __forceinline__ void gemm_phase(const int tid, LAS unsigned char* lds, const int lda, const int ldb, const Sched& S, const Epi& E) {
    const int wid = __builtin_amdgcn_readfirstlane(tid >> 6), lane = tid & 63, wr = wid >> 2, wc = wid & 3, fr = lane & 15, fq = lane >> 4;
    unsigned voffA[2], voffB[2];
#pragma unroll
    for (int i = 0; i < 2; ++i) { int R, C; stage_rc(tid * 16 + i * 8192, R, C); const int Rb = (R & ~31) + perm32(R & 31);
        voffA[i] = (unsigned)(R * lda + C) * 2u; voffB[i] = (unsigned)(Rb * ldb + C) * 2u; }
    const size_t kstep = (size_t)(BK * 2);
    const size_t hstepA = (size_t)HALF * lda * 2, hstepB = (size_t)HALF * ldb * 2;
    const unsigned ldsw = (unsigned)wid * 1024u;
    const int aoff = lds_byte(wr * 64 + fr, fq * 8), boff = lds_byte(wc * 32 + fr, fq * 8);
#define PG8_SA(b, h) (((b) * 2 + (h)) * HTB)
#define PG8_SB(b, h) ((4 + (b) * 2 + (h)) * HTB)
#define PG8_STAGE(bufoff, gbase, voff) do { _Pragma("unroll") for (int _i = 0; _i < 2; ++_i) \
        __builtin_amdgcn_global_load_lds((const unsigned*)((const char*)(gbase) + (voff)[_i]), (LAS unsigned*)(lds + (bufoff) + ldsw + _i * 8192), 16, 0, 0); } while (0)
#define PG8_LDA(dst, b, h) do { _Pragma("unroll") for (int m = 0; m < 4; ++m) _Pragma("unroll") for (int k = 0; k < 2; ++k) dst[m][k] = *(const LAS bf16x8*)(lds + PG8_SA(b, h) + aoff + m * 2048 + k * 1024); } while (0)
#define PG8_LDB(dst, b, h) do { _Pragma("unroll") for (int n = 0; n < 2; ++n) _Pragma("unroll") for (int k = 0; k < 2; ++k) dst[n][k] = *(const LAS bf16x8*)(lds + PG8_SB(b, h) + boff + n * 2048 + k * 1024); } while (0)
#define PG8_MMA(ai, bj, At, Bt) do { __builtin_amdgcn_s_setprio(1); _Pragma("unroll") for (int m = 0; m < 4; ++m) _Pragma("unroll") for (int n = 0; n < 2; ++n) _Pragma("unroll") for (int k = 0; k < 2; ++k) \
        acc[ai][bj][m][n] = __builtin_amdgcn_mfma_f32_16x16x32_bf16(Bt[n][k], At[m][k], acc[ai][bj][m][n], 0, 0, 0); __builtin_amdgcn_s_setprio(0); } while (0)
#define PG8_WAIT_V(n) asm volatile("s_waitcnt vmcnt(" #n ")" ::: "memory")
#define PG8_WAIT_L(n) asm volatile("s_waitcnt lgkmcnt(" #n ")" ::: "memory")
#define PG8_BAR __builtin_amdgcn_s_barrier()
#define PG8_SCHED __builtin_amdgcn_sched_barrier(0)
    Unit cur, nxt; int ui = 0;
    if (!S.next(0, cur)) return;
    f32x4 acc[2][2][4][2];
#pragma unroll
    for (int a = 0; a < 2; ++a)
#pragma unroll
        for (int b = 0; b < 2; ++b)
#pragma unroll
            for (int m = 0; m < 4; ++m)
#pragma unroll
                for (int n = 0; n < 2; ++n) acc[a][b][m][n] = (f32x4){0.f, 0.f, 0.f, 0.f};
    bf16x8 At[4][2], B0[2][2], B1[2][2];
    const char* cA = cur.a; const char* cB = cur.b;
    PG8_STAGE(PG8_SB(0, 0), cB, voffB); PG8_STAGE(PG8_SB(0, 1), cB + hstepB, voffB); PG8_STAGE(PG8_SA(0, 0), cA, voffA); PG8_STAGE(PG8_SA(0, 1), cA + hstepA, voffA);
    if (wr == 1) PG8_BAR;
    PG8_WAIT_V(2); PG8_BAR;
    PG8_STAGE(PG8_SB(1, 0), cB + kstep, voffB); PG8_STAGE(PG8_SA(1, 0), cA + kstep, voffA); PG8_STAGE(PG8_SB(1, 1), cB + hstepB + kstep, voffB);
    PG8_WAIT_V(6); PG8_BAR;
    for (;;) {
        const bool has_next = S.next(ui + 1, nxt);
        const char* nA = has_next ? nxt.a : cA; const char* nB = has_next ? nxt.b : cB;
        const int nt = cur.nt;
        for (int t = 0; t < nt; t += 2) {
            if constexpr (Epi::HOOK) { if (t == 8 || t == 16) { if (wr == 0) PG8_BAR; E.hook(acc, cur, (t >> 3) - 1, wr, wc, fr, fq); if (wr == 1) PG8_BAR; } }
            const bool last = (t == nt - 2);
            const char* a1 = cA + (size_t)(t + 1) * kstep;
            const char* a2 = last ? nA : cA + (size_t)(t + 2) * kstep; const char* b2 = last ? nB : cB + (size_t)(t + 2) * kstep;
            const char* a3 = a2 + kstep; const char* b3 = b2 + kstep;
            PG8_LDB(B0, 0, 0); PG8_LDB(B1, 0, 1); PG8_SCHED; PG8_LDA(At, 0, 0); PG8_STAGE(PG8_SA(1, 1), a1 + hstepA, voffA);
            PG8_WAIT_V(8); PG8_WAIT_L(0); PG8_BAR; PG8_MMA(0, 0, At, B0); PG8_MMA(0, 1, At, B1); PG8_BAR; PG8_SCHED;
            PG8_LDA(At, 0, 1); PG8_STAGE(PG8_SB(0, 0), b2, voffB); PG8_STAGE(PG8_SB(0, 1), b2 + hstepB, voffB); PG8_STAGE(PG8_SA(0, 0), a2, voffA);
            PG8_WAIT_V(8); PG8_WAIT_L(0); PG8_BAR; PG8_MMA(1, 0, At, B0); PG8_MMA(1, 1, At, B1); PG8_BAR; PG8_SCHED;
            PG8_LDB(B0, 1, 0); PG8_LDB(B1, 1, 1); PG8_SCHED; PG8_LDA(At, 1, 0); PG8_STAGE(PG8_SA(0, 1), a2 + hstepA, voffA);
            PG8_WAIT_V(8); PG8_WAIT_L(0); PG8_BAR; PG8_MMA(0, 0, At, B0); PG8_MMA(0, 1, At, B1); PG8_BAR; PG8_SCHED;
            PG8_LDA(At, 1, 1); PG8_STAGE(PG8_SB(1, 0), b3, voffB); PG8_STAGE(PG8_SB(1, 1), b3 + hstepB, voffB); PG8_STAGE(PG8_SA(1, 0), a3, voffA);
            PG8_WAIT_V(8); PG8_WAIT_L(0); PG8_BAR; PG8_MMA(1, 0, At, B0); PG8_MMA(1, 1, At, B1); PG8_BAR; PG8_SCHED;
        }
        if (wr == 0) PG8_BAR;
        E(acc, cur, wr, wc, fr, fq);
        if (!has_next) break;
#pragma unroll
        for (int a = 0; a < 2; ++a)
#pragma unroll
            for (int b = 0; b < 2; ++b)
#pragma unroll
                for (int m = 0; m < 4; ++m)
#pragma unroll
                    for (int n = 0; n < 2; ++n) acc[a][b][m][n] = (f32x4){0.f, 0.f, 0.f, 0.f};
        cur = nxt; cA = nA; cB = nB; ++ui;
        if (wr == 1) PG8_BAR;
    }
    PG8_WAIT_V(0);
    PG8_BAR;
#undef PG8_SA
#undef PG8_SB
#undef PG8_STAGE
#undef PG8_LDA
#undef PG8_LDB
#undef PG8_MMA
#undef PG8_WAIT_V
#undef PG8_WAIT_L
#undef PG8_BAR
#undef PG8_SCHED
}

struct TileSched {
    int nM, nN, nwg, G, c; const char* A; const char* Bt; size_t atile, btile; int nt;
    int nchunk = 0, nlat_mine = 0;
    __device__ __forceinline__ void init(int nM_, int nN_, int G_, int c_, const void* A_, int lda, const void* Bt_, int ldb, int K) {
        nM = nM_; nN = nN_; nwg = nM * nN; G = G_; c = c_; A = (const char*)A_; Bt = (const char*)Bt_; atile = (size_t)BM * lda * 2; btile = (size_t)BM * ldb * 2; nt = K / BK; }
    __device__ __forceinline__ void split_ctx(int nchunk_) { nchunk = nchunk_; nlat_mine = c < nwg ? (nwg - c + G - 1) / G : 0; }
    __device__ __forceinline__ bool next(int i, Unit& u) const {
        if (nchunk > 0 && i >= nlat_mine) {
            const long s = (long)(i - nlat_mine) * G + c; if (s >= 2 * nN * nchunk) return false;
            const int chunk = (int)s % nchunk, up = (int)s / nchunk, ntc = nt / nchunk;
            u.pm = 64 + up / nN; u.pn = up % nN; u.nt = ntc; u.kind = 1 + chunk;
            u.a = A + (size_t)u.pm * atile + (size_t)chunk * ntc * (BK * 2); u.b = Bt + (size_t)u.pn * btile + (size_t)chunk * ntc * (BK * 2); return true;
        }
        const long L = (long)i * G + c; if (L >= nwg) return false;
        int wgid = (int)L; { const int q = nwg / NXCD, r = nwg % NXCD, xcd = wgid % NXCD, off = wgid / NXCD; wgid = (xcd < r ? xcd * (q + 1) : r * (q + 1) + (xcd - r) * q) + off; }
        const int nig = WGM * nN, gid = wgid / nig, fm = gid * WGM, gsz = (nM - fm) < WGM ? (nM - fm) : WGM;
        u.pm = fm + ((wgid % nig) % gsz); u.pn = (wgid % nig) / gsz;
        u.a = A + (size_t)u.pm * atile; u.b = Bt + (size_t)u.pn * btile; u.nt = nt; u.kind = 0; return true;
    }
};
__device__ __forceinline__ size_t gate_tile(int br, int pm, int pn) { return ((size_t)((br * 66 + pm) * 4 + pn)) * 65536; }
enum { EK_QKV = 0, EK_UKV, EK_GATE, EK_MERGE, EK_RES, EK_SQRELU };
template <int EK> struct Epi {
    bf16_t* o0; bf16_t* o1;
    const bf16_t* gates;
    const float* xin_lat; const float* xin_ctx; float* xout_lat; float* xout_ctx; const float* gmod; float* part;
    static constexpr bool HOOK = (EK == EK_MERGE);
    __device__ __forceinline__ void hook(f32x4 (&acc)[2][2][4][2], const Unit& u, const int seg, int wr, int wc, int fr, int fq) const {
        const int tid8 = (((wr * 4 + wc) * 64) + fq * 16 + fr) * 8;
        const GAS bf16_t* gp = (const GAS bf16_t*)gates + gate_tile(seg, u.pm, u.pn) + tid8;
        constexpr size_t NEXT = (size_t)66 * 4 * 65536;
#pragma unroll
        for (int ai = 0; ai < 2; ++ai) {
            asm volatile("" : "+v"(gp));
#pragma unroll
            for (int m = 0; m < 4; ++m) {
#pragma unroll
                for (int bj = 0; bj < 2; ++bj) {
                    const u32x4 ga = *(const GAS u32x4*)(gp + bj * 4096), gb = *(const GAS u32x4*)(gp + bj * 4096 + NEXT);
                    f32x4 r0, r1;
                    r0[0] = bflo(ga.x) * __builtin_amdgcn_rcpf(bflo(gb.x)); r0[1] = bfhi(ga.x) * __builtin_amdgcn_rcpf(bfhi(gb.x));
                    r0[2] = bflo(ga.y) * __builtin_amdgcn_rcpf(bflo(gb.y)); r0[3] = bfhi(ga.y) * __builtin_amdgcn_rcpf(bfhi(gb.y));
                    r1[0] = bflo(ga.z) * __builtin_amdgcn_rcpf(bflo(gb.z)); r1[1] = bfhi(ga.z) * __builtin_amdgcn_rcpf(bfhi(gb.z));
                    r1[2] = bflo(ga.w) * __builtin_amdgcn_rcpf(bflo(gb.w)); r1[3] = bfhi(ga.w) * __builtin_amdgcn_rcpf(bfhi(gb.w));
                    acc[ai][bj][m][0] *= r0; acc[ai][bj][m][1] *= r1;
                }
                gp += 2 * 4096;
            }
        }
    }
    __device__ __forceinline__ void operator()(f32x4 (&acc)[2][2][4][2], const Unit& u, int wr, int wc, int fr, int fq) const {
        const int row0 = u.pm * BM + wr * 64 + fr, colb = u.pn * BM + wc * 32 + 8 * fq;
        if (EK == EK_RES && u.kind > 0) {
            float* pp = part + (size_t)(u.kind - 1) * NCTX * DM - (size_t)NLAT * DM; const float* gm = gmod + 2 * 6144;
#pragma unroll
            for (int bj = 0; bj < 2; ++bj) { const int col = colb + bj * HALF; const f32x4 g0 = *(const f32x4*)(gm + col), g1 = *(const f32x4*)(gm + col + 4);
#pragma unroll
                for (int ai = 0; ai < 2; ++ai)
#pragma unroll
                    for (int m = 0; m < 4; ++m) { const size_t off = (size_t)(row0 + ai * HALF + m * 16) * DM + col;
                        *(f32x4*)(pp + off) = g0 * acc[ai][bj][m][0]; *(f32x4*)(pp + off + 4) = g1 * acc[ai][bj][m][1]; } }
            return;
        }
        if (EK == EK_RES) {
            const bool isctx = u.pm >= 64;
            const float* xi = isctx ? xin_ctx - (size_t)NLAT * DM : xin_lat; float* xo = isctx ? xout_ctx - (size_t)NLAT * DM : xout_lat;
            const float* gm = gmod + (u.pm < 32 ? 0 : (u.pm < 64 ? 1 : 2)) * 6144;
#pragma unroll
            for (int bj = 0; bj < 2; ++bj) { const int col = colb + bj * HALF; const f32x4 g0 = *(const f32x4*)(gm + col), g1 = *(const f32x4*)(gm + col + 4);
#pragma unroll
                for (int ai = 0; ai < 2; ++ai)
#pragma unroll
                    for (int m = 0; m < 4; ++m) { const size_t off = (size_t)(row0 + ai * HALF + m * 16) * DM + col;
                        const f32x4 x0 = *(const f32x4*)(xi + off), x1 = *(const f32x4*)(xi + off + 4);
                        *(f32x4*)(xo + off) = x0 + g0 * acc[ai][bj][m][0]; *(f32x4*)(xo + off + 4) = x1 + g1 * acc[ai][bj][m][1]; } }
            return;
        }
        bf16_t* base; int ld, col0 = colb;
        if (EK == EK_QKV) { if (u.pn < 7) { base = o0; ld = PQ_LD; if (u.pn >= 4) col0 = colb + 512; } else { base = o1; ld = PKV_LD; col0 = colb - 7 * BM; } }
        else if (EK == EK_UKV) { if (u.pn < 2) { base = o0; ld = 512; } else { base = o1; ld = 512; col0 = colb - 512; } }
        else if (EK == EK_GATE) { base = o0; ld = GATE_LD; }
        else if (EK == EK_MERGE) { base = o0; ld = DM; }
        else { base = o0; ld = DFF; }
#pragma unroll
        for (int ai = 0; ai < 2; ++ai)
#pragma unroll
            for (int m = 0; m < 4; ++m) { const int row = row0 + ai * HALF + m * 16; bf16_t* rowp = base + (size_t)row * ld + col0;
#pragma unroll
                for (int bj = 0; bj < 2; ++bj) { f32x4 v0 = acc[ai][bj][m][0], v1 = acc[ai][bj][m][1];
                    if (EK == EK_GATE) {
#pragma unroll
                        for (int e = 0; e < 4; ++e) { v0[e] = fast_sigmoid(v0[e]); v1[e] = fast_sigmoid(v1[e]); } }
                    if (EK == EK_SQRELU) {
#pragma unroll
                        for (int e = 0; e < 4; ++e) { const float a = fmaxf(v0[e], 0.f), b = fmaxf(v1[e], 0.f); v0[e] = a * a; v1[e] = b * b; } }
                    if (EK == EK_MERGE) { const u32x4 g = *(const u32x4*)(gates + gate_tile(2, u.pm, u.pn) + (size_t)((ai * 4 + m) * 2 + bj) * 4096 + ((((wr * 4 + wc) * 64) + fq * 16 + fr) * 8));
                        v0[0] *= bflo(g.x); v0[1] *= bfhi(g.x); v0[2] *= bflo(g.y); v0[3] *= bfhi(g.y); v1[0] *= bflo(g.z); v1[1] *= bfhi(g.z); v1[2] *= bflo(g.w); v1[3] *= bfhi(g.w); }
                    u32x4 w; w.x = pk2(v0[0], v0[1]); w.y = pk2(v0[2], v0[3]); w.z = pk2(v1[0], v1[1]); w.w = pk2(v1[2], v1[3]);
                    if (EK == EK_GATE) *(u32x4*)(o0 + gate_tile(u.pn >> 2, u.pm, u.pn & 3) + (size_t)((ai * 4 + m) * 2 + bj) * 4096 + ((((wr * 4 + wc) * 64) + fq * 16 + fr) * 8)) = w;
                    else *(u32x4*)(rowp + bj * HALF) = w; } }
    }
};
}

__device__ __forceinline__ int crow(int r, int hi) { return (r & 3) + 8 * (r >> 2) + 4 * hi; }
__device__ __forceinline__ float max3f(float a, float b, float c) { return fmaxf(fmaxf(a, b), c); }
__device__ __forceinline__ s16x4 vtr(const LAS unsigned char* p) { return __builtin_bit_cast(s16x4, __builtin_amdgcn_ds_read_tr16_b64_v4i16((LAS s16x4*)p)); }

template <int DK, bool NA>
__device__ __forceinline__ void attn_unit(const int tid, LAS unsigned char* lds,
        const bf16_t* __restrict__ q, bf16_t* o,
        const bf16_t* __restrict__ kbase, const bf16_t* __restrict__ vbase, const bf16_t* __restrict__ krbase,
        const int row_lat, const int row_ctx, int n_lat, float c, const float* __restrict__ rpb, int r0, int rs0, const bool nomax = false) {
    constexpr int KP = DK * 2 + 16, VP = 192, KBUF = 64 * KP, VBUF = 64 * VP, ND = DK / 16;
    constexpr bool VPF = false, KPF = false; constexpr int qld = PQ_LD, old_ = PQ_LD, kld = (DK == 96) ? 512 : PKV_LD, vld = kld;
    const int lane = tid & 63, r32 = lane & 31, hi = lane >> 5, wid = __builtin_amdgcn_readfirstlane(tid >> 6);
    LAS unsigned char* Ks = lds; LAS unsigned char* Vs = lds + 2 * KBUF;
    LAS float* rp = (LAS float*)(lds + 2 * KBUF + 2 * VBUF) + 64;
    const int NT = n_lat + 4;
    const int lkey = tid >> 3, lpart = tid & 7, lkey2 = tid >> 3, lpart2 = tid & 7;
    const unsigned kdst = lkey * KP + lpart * 16, vdst = lkey * VP + lpart * 16, k2dst = lkey2 * KP + 128 + lpart2 * 8;
    u32x4 kregA, vregA, kregB, vregB; u32x2 kreg2A, kreg2B;
#define ATT_LOADK(t, kreg, kreg2) do { const int tk_ = (t); const int rr_ = (tk_ < n_lat) ? row_lat + tk_ * 64 : row_ctx + (tk_ - n_lat) * 64; \
        kreg = *(const u32x4*)(kbase + (size_t)(rr_ + lkey) * kld + lpart * 8); \
        if (DK == 96) kreg2 = *(const u32x2*)(krbase + (size_t)(rr_ + lkey2) * 32 + lpart2 * 4); } while (0)
#define ATT_LOADV(t, vreg) do { const int tv_ = (t); const int rr_ = (tv_ < n_lat) ? row_lat + tv_ * 64 : row_ctx + (tv_ - n_lat) * 64; \
        vreg = *(const u32x4*)(vbase + (size_t)(rr_ + lkey) * vld + lpart * 8); } while (0)
#define ATT_STOREK(buf, kreg, kreg2) do { *(LAS u32x4*)(Ks + (buf) * KBUF + kdst) = kreg; if (DK == 96) *(LAS u32x2*)(Ks + (buf) * KBUF + k2dst) = kreg2; } while (0)
#define ATT_STOREV(buf, vreg) do { *(LAS u32x4*)(Vs + (buf) * VBUF + vdst) = vreg; } while (0)
#define ATT_MFMA __builtin_amdgcn_mfma_f32_32x32x16_bf16
#define ATT_KLOAD(kbuf) do { const LAS unsigned char* Kb_ = Ks + (kbuf) * KBUF + kaddr; \
        _Pragma("unroll") for (int d0 = 0; d0 < ND; ++d0) { kf[d0][0] = *(const LAS bf16x8*)(Kb_ + d0 * 32); kf[d0][1] = *(const LAS bf16x8*)(Kb_ + 32 * KP + d0 * 32); } } while (0)
#define ATT_QK(P0, P1, kbuf, INIT) do { if (!KPF) ATT_KLOAD(kbuf); \
        _Pragma("unroll") for (int d0 = 0; d0 < ND; ++d0) { \
            if (d0 == 0) { P0 = ATT_MFMA(kf[0][0], qf[0], INIT, 0, 0, 0); P1 = ATT_MFMA(kf[0][1], qf[0], INIT, 0, 0, 0); } \
            else { P0 = ATT_MFMA(kf[d0][0], qf[d0], P0, 0, 0, 0); P1 = ATT_MFMA(kf[d0][1], qf[d0], P1, 0, 0, 0); } } } while (0)
    ATT_LOADK(0, kregA, kreg2A); ATT_LOADV(0, vregA);
    bf16x8 qf[ND];
    { const bf16_t* qrow = q + (size_t)(wid * 32 + r32) * qld + hi * 8;
#pragma unroll
      for (int d0 = 0; d0 < ND; ++d0) { const u32x4 w = *(const u32x4*)(qrow + d0 * 16); u32x4 s;
          s.x = pk2(bflo(w.x) * c, bfhi(w.x) * c); s.y = pk2(bflo(w.y) * c, bfhi(w.y) * c); s.z = pk2(bflo(w.z) * c, bfhi(w.z) * c); s.w = pk2(bflo(w.w) * c, bfhi(w.w) * c);
          qf[d0] = __builtin_bit_cast(bf16x8, s); } }
    int qc = 0, cs = 0, rq = 0, rsq = 0;
    if (NA) { qc = 32 * (wid & 1) + r32; cs = min(max(qc - 8, 0), 48); rq = r0 + (wid >> 1); rsq = min(max(rq - 4, 0), 120);
        if (tid < 465) rp[tid] = rpb[tid] * LOG2E; }
    ATT_STOREK(0, kregA, kreg2A); ATT_STOREV(0, vregA);
    ATT_LOADK(1, kregA, kreg2A); ATT_STOREK(1, kregA, kreg2A);
    ATT_LOADK(2, kregA, kreg2A); ATT_LOADV(1, vregA);
    __syncthreads();
    const int g_ = lane >> 4, q_ = (lane & 15) >> 2, p_ = lane & 3;
    const unsigned vaddr = (4 * (g_ >> 1) + q_) * VP + (16 * (g_ & 1) + 4 * p_) * 2;
    const unsigned kaddr = r32 * KP + hi * 16;
    float l_run = 0.f, mxa = 0.f, mxb = 0.f; bool first = true;
    f32x16 o0 = {}, o1 = {}, negm = {};
    f32x16 sa0 = {}, sa1 = {}, sb0 = {}, sb1 = {};
#define ATT_BIASMAX(P0, P1, MX, tt) do { const int tb_ = (tt); \
        if (NA && tb_ < n_lat) { const int bi_ = (rs0 + tb_ - rq + 7) * 31 + 15 - qc; \
            _Pragma("unroll") for (int r = 0; r < 16; ++r) { const int cj = crow(r, hi); \
                P0[r] = ((unsigned)(cj - cs) < 16u) ? P0[r] + rp[bi_ + cj] : -INFINITY; \
                P1[r] = ((unsigned)(cj + 32 - cs) < 16u) ? P1[r] + rp[bi_ + cj + 32] : -INFINITY; } } \
        if (!NA && nomax) { MX = 0.f; break; }                       \
        float mx_ = max3f(P0[0], P0[1], P1[0]), mb_ = max3f(P0[2], P0[3], P1[1]); mx_ = max3f(mx_, P1[2], P1[3]); \
        _Pragma("unroll") for (int r = 4; r < 16; r += 4) { mx_ = max3f(mx_, P0[r], P0[r + 1]); mb_ = max3f(mb_, P0[r + 2], P0[r + 3]); mx_ = max3f(mx_, P1[r], P1[r + 1]); mb_ = max3f(mb_, P1[r + 2], P1[r + 3]); } \
        MX = swap_max(fmaxf(mx_, mb_)); } while (0)
#define ATT_ACTIVE(tt) (!(NA && (tt) < n_lat) || ((rs0 + (tt) >= rsq) && (rs0 + (tt) < rsq + 8)))
    bf16x8 kf[ND][2];
    if (ATT_ACTIVE(0)) { if (KPF) ATT_KLOAD(0); ATT_QK(sa0, sa1, 0, negm); ATT_BIASMAX(sa0, sa1, mxa, 0); }
    __syncthreads();
#define ATT_ITER(t, PA0, PA1, PB0, PB1, MXA, MXB, KI, K2I, VI, KS, K2S, VS) do { const int t_ = (t); const bool hk_ = t_ + 2 < NT, hv_ = t_ + 1 < NT; \
        if (t_ + 3 < NT) ATT_LOADK(t_ + 3, KI, K2I);                  \
        if (t_ + 2 < NT) ATT_LOADV(t_ + 2, VI); \
        const bool act_ = ATT_ACTIVE(t_), actn_ = NA ? (hv_ && ATT_ACTIVE(t_ + 1)) : true; \
        if (act_) { if (first || __any(MXA > 8.f)) {                 \
                const float d_ = first ? MXA : fmaxf(MXA, 0.f), alpha_ = __builtin_amdgcn_exp2f(-d_); \
                PA0 -= d_; PA1 -= d_; negm -= d_; l_run *= alpha_; o0 *= alpha_; o1 *= alpha_; first = false; } } \
        s16x4 vq_[4][4]; \
        if (KPF && actn_) ATT_KLOAD((t_ + 1) & 1); \
        if (VPF && act_) { const LAS unsigned char* Vb_ = Vs + (t_ & 1) * VBUF + vaddr; \
            _Pragma("unroll") for (int s = 0; s < 4; ++s) { const int ro_ = (16 * (s & 1) + 32 * (s >> 1)) * VP; \
                vq_[s][0] = vtr(Vb_ + ro_); vq_[s][1] = vtr(Vb_ + ro_ + 8 * VP); vq_[s][2] = vtr(Vb_ + ro_ + 64); vq_[s][3] = vtr(Vb_ + ro_ + 8 * VP + 64); } } \
        if (KPF) __builtin_amdgcn_sched_barrier(0); \
        __builtin_amdgcn_s_setprio(1); \
        if (actn_) ATT_QK(PB0, PB1, (t_ + 1) & 1, negm); \
        if (act_) { \
            float ps_ = 0.f; \
            _Pragma("unroll") for (int r = 0; r < 16; ++r) { PA0[r] = __builtin_amdgcn_exp2f(PA0[r]); PA1[r] = __builtin_amdgcn_exp2f(PA1[r]); ps_ += PA0[r] + PA1[r]; } \
            l_run += ps_; \
            bf16x8 pa_[4]; \
            _Pragma("unroll") for (int s = 0; s < 2; ++s) { u32x4 w0, w1; \
                w0.x = pk2(PA0[8 * s + 0], PA0[8 * s + 1]); w0.y = pk2(PA0[8 * s + 2], PA0[8 * s + 3]); w0.z = pk2(PA0[8 * s + 4], PA0[8 * s + 5]); w0.w = pk2(PA0[8 * s + 6], PA0[8 * s + 7]); \
                w1.x = pk2(PA1[8 * s + 0], PA1[8 * s + 1]); w1.y = pk2(PA1[8 * s + 2], PA1[8 * s + 3]); w1.z = pk2(PA1[8 * s + 4], PA1[8 * s + 5]); w1.w = pk2(PA1[8 * s + 6], PA1[8 * s + 7]); \
                pa_[s] = __builtin_bit_cast(bf16x8, w0); pa_[2 + s] = __builtin_bit_cast(bf16x8, w1); } \
            const LAS unsigned char* Vc_ = Vs + (t_ & 1) * VBUF + vaddr; \
            _Pragma("unroll") for (int s = 0; s < 4; ++s) { const int ro_ = (16 * (s & 1) + 32 * (s >> 1)) * VP; \
                if (!VPF) { vq_[s][0] = vtr(Vc_ + ro_); vq_[s][1] = vtr(Vc_ + ro_ + 8 * VP); vq_[s][2] = vtr(Vc_ + ro_ + 64); vq_[s][3] = vtr(Vc_ + ro_ + 8 * VP + 64); } \
                const s16x4 a0 = vq_[s][0], a1 = vq_[s][1], b0 = vq_[s][2], b1 = vq_[s][3]; \
                const bf16x8 vf0 = {a0[0], a0[1], a0[2], a0[3], a1[0], a1[1], a1[2], a1[3]}, vf1 = {b0[0], b0[1], b0[2], b0[3], b1[0], b1[1], b1[2], b1[3]}; \
                o0 = ATT_MFMA(vf0, pa_[s], o0, 0, 0, 0); o1 = ATT_MFMA(vf1, pa_[s], o1, 0, 0, 0); } \
        } \
        if (actn_) ATT_BIASMAX(PB0, PB1, MXB, t_ + 1); \
        __builtin_amdgcn_s_setprio(0); \
        if (hk_) ATT_STOREK(t_ & 1, KS, K2S); \
        if (hv_) ATT_STOREV((t_ + 1) & 1, VS); \
        asm volatile("s_waitcnt lgkmcnt(0)\n\ts_barrier" ::: "memory"); } while (0)
    for (int t = 0; t < NT; t += 2) {
        ATT_ITER(t, sa0, sa1, sb0, sb1, mxa, mxb, kregB, kreg2B, vregB, kregA, kreg2A, vregA);
        if (t + 1 < NT) ATT_ITER(t + 1, sb0, sb1, sa0, sa1, mxb, mxa, kregA, kreg2A, vregA, kregB, kreg2B, vregB);
    }
    const float inv = 1.f / swap_sum(l_run);
    bf16_t* orow = o + (size_t)(wid * 32 + r32) * old_ + 4 * hi;
#pragma unroll
    for (int a = 0; a < 4; ++a) {
        u32x2 w0, w1;
        w0.x = pk2(o0[4 * a] * inv, o0[4 * a + 1] * inv); w0.y = pk2(o0[4 * a + 2] * inv, o0[4 * a + 3] * inv);
        w1.x = pk2(o1[4 * a] * inv, o1[4 * a + 1] * inv); w1.y = pk2(o1[4 * a + 2] * inv, o1[4 * a + 3] * inv);
        *(u32x2*)(orow + 8 * a) = w0; *(u32x2*)(orow + 32 + 8 * a) = w1;
    }
#undef ATT_LOADK
#undef ATT_LOADV
#undef ATT_STOREK
#undef ATT_STOREV
#undef ATT_QK
#undef ATT_KLOAD
#undef ATT_ITER
#undef ATT_BIASMAX
#undef ATT_ACTIVE
#undef ATT_MFMA
}


#define XB_TMO      128
#define XB_XCNT(j)  (256  + 64 * (j))
#define XB_XSUB(j)  (1280 + 64 * (j))
#define XB_XGEN(j)  (2304 + 64 * (j))
#define XB_TOP      3328
#define XB_TOPGEN   3392
#define XCD_BAR_WORDS 3456
#define XB_SPIN_CAP (1u << 20)
__device__ __forceinline__ unsigned xb_ld(unsigned* p)              { return __hip_atomic_load(p, __ATOMIC_RELAXED, __HIP_MEMORY_SCOPE_AGENT); }
__device__ __forceinline__ unsigned xb_add(unsigned* p, unsigned v) { return __hip_atomic_fetch_add(p, v, __ATOMIC_RELAXED, __HIP_MEMORY_SCOPE_AGENT); }
__device__ __forceinline__ unsigned xb_xcc_id() { return (unsigned)__builtin_amdgcn_s_getreg((3 << 11) | 20) & 0xFu; }
#define XB_SPIN(cond, bar) do { unsigned _sp = 0; while (cond) { __builtin_amdgcn_s_sleep(1); \
    if ((++_sp & 255u) == 0u) { if (xb_ld(&(bar)[XB_TMO])) break; if (_sp > XB_SPIN_CAP) { atomicAdd(&(bar)[XB_TMO], 1u); break; } } } } while (0)
struct XcdBarrier { unsigned* bar; unsigned x; volatile LAS unsigned* st; };
__device__ __forceinline__ XcdBarrier xcd_barrier_post(unsigned* bar, volatile LAS unsigned* st) {
    XcdBarrier b; b.bar = bar; b.x = xb_xcc_id(); b.st = st;
    if (threadIdx.x == 0) (void)xb_add(&bar[XB_XCNT(b.x)], 1u);
    return b;
}
__device__ __forceinline__ void xcd_barrier_complete(unsigned* bar, unsigned x, unsigned& nloc, unsigned& nx) {
    const unsigned G = gridDim.x * gridDim.y * gridDim.z;
    unsigned sum, cnt, mine, sp = 0u;
    for (;;) {
        sum = 0u; cnt = 0u; mine = 0u;
#pragma unroll
        for (unsigned j = 0; j < 16; ++j) { const unsigned c = xb_ld(&bar[XB_XCNT(j)]); sum += c; cnt += (c > 0u) ? 1u : 0u; mine = (j == x) ? c : mine; }
        if (sum == G) break;
        __builtin_amdgcn_s_sleep(1);
        if ((++sp & 255u) == 0u) { if (xb_ld(&bar[XB_TMO])) break; if (sp > XB_SPIN_CAP) { atomicAdd(&bar[XB_TMO], 1u); break; } }
    }
    nloc = mine > 0u ? mine : 1u; nx = cnt > 0u ? cnt : 1u;
}
__device__ __forceinline__ void xcd_barrier(const XcdBarrier& b) {
    asm volatile("s_waitcnt vmcnt(0)" ::: "memory");
    __syncthreads();
    if (threadIdx.x == 0) {
        unsigned* bar = b.bar;
        __builtin_amdgcn_s_waitcnt(0);
        unsigned nloc = b.st[0], nx = b.st[1];
        if (nloc == 0u) { xcd_barrier_complete(bar, b.x, nloc, nx); b.st[0] = nloc; b.st[1] = nx; }
        const unsigned old = xb_add(&bar[XB_XSUB(b.x)], 1u);
        const unsigned gen = old / nloc;
        if (old + 1u == (gen + 1u) * nloc) {
            __builtin_amdgcn_fence(__ATOMIC_RELEASE, "agent");
            asm volatile("s_waitcnt vmcnt(0)" ::: "memory");
            const unsigned og = xb_add(&bar[XB_TOP], 1u);
            const unsigned tg = og / nx;
            if (og + 1u == (tg + 1u) * nx) xb_add(&bar[XB_TOPGEN], 1u);
            else XB_SPIN(xb_ld(&bar[XB_TOPGEN]) == tg, bar);
            __builtin_amdgcn_fence(__ATOMIC_ACQUIRE, "agent");
            xb_add(&bar[XB_XGEN(b.x)], 1u);
            asm volatile("s_waitcnt vmcnt(0)" ::: "memory");
        } else {
            XB_SPIN(xb_ld(&bar[XB_XGEN(b.x)]) == gen, bar);
            __builtin_amdgcn_fence(__ATOMIC_ACQUIRE, "agent");
            asm volatile("s_waitcnt vmcnt(0)" ::: "memory");
        }
    }
    __syncthreads();
}

struct Args { const float* in[22]; float* out; unsigned char* ws; int ph_lo, ph_hi; };
#define AIN(k) (a.in[(k) + zofs])

__device__ __forceinline__ void wconv(const float* __restrict__ W, int K, int ldw, int c0, int n, bf16_t* __restrict__ Wt, int r0, int ldt, int koff, LAS float* sm, int& rot, int G, int bid, const int tid) {
    const int nkt = K / 128, nnt = n / 32, ntiles = nkt * nnt, ngroups = (ntiles + 3) >> 2;
    int start = bid - rot; if (start < 0) start += G;
    int par = 0;
    for (int g = start; g < ngroups; g += G) {
        LAS float* smb = sm + par * (4 * 128 * 33); par ^= 1;
        f32x4 v[4][2];
#pragma unroll
        for (int j = 0; j < 4; ++j) { const int t = g * 4 + j;
            if (t < ntiles) { const int kt = t / nnt, ntile = t - kt * nnt, k0 = kt * 128, n0 = ntile * 32;
#pragma unroll
                for (int i = 0; i < 2; ++i) v[j][i] = __builtin_nontemporal_load((const f32x4*)(W + (size_t)(k0 + (tid >> 3) + 64 * i) * ldw + c0 + n0 + (tid & 7) * 4)); } }
#pragma unroll
        for (int j = 0; j < 4; ++j) { const int t = g * 4 + j;
            if (t < ntiles) {
#pragma unroll
                for (int i = 0; i < 2; ++i) { LAS float* p = smb + j * (128 * 33) + ((tid >> 3) + 64 * i) * 33 + (tid & 7) * 4; p[0] = v[j][i][0]; p[1] = v[j][i][1]; p[2] = v[j][i][2]; p[3] = v[j][i][3]; } } }
        __syncthreads();
#pragma unroll
        for (int j = 0; j < 4; ++j) { const int t = g * 4 + j;
            if (t < ntiles) { const int kt = t / nnt, ntile = t - kt * nnt, k0 = kt * 128, n0 = ntile * 32;
                const LAS float* p = smb + j * (128 * 33); const int nn = tid >> 4, k8 = (tid & 15) * 8; u32x4 w;
                w.x = pk2(p[(k8 + 0) * 33 + nn], p[(k8 + 1) * 33 + nn]); w.y = pk2(p[(k8 + 2) * 33 + nn], p[(k8 + 3) * 33 + nn]);
                w.z = pk2(p[(k8 + 4) * 33 + nn], p[(k8 + 5) * 33 + nn]); w.w = pk2(p[(k8 + 6) * 33 + nn], p[(k8 + 7) * 33 + nn]);
                *(u32x4*)(Wt + (size_t)(r0 + n0 + nn) * ldt + koff + k0 + k8) = w; } }
    }
    __syncthreads();
    rot = (rot + ngroups) % G;
}

__device__ __forceinline__ void convert_weights(const Args& a, const int zofs, int l, LAS float* sm, int G, int bid, const int tid, const int groups = 7) {
    unsigned char* ws = a.ws; int rot = 0;
    if (groups & 1) {
    bf16_t* WINT = (bf16_t*)(ws + WS_WINT); const float* win = AIN(8) + (size_t)l * DM * WIN_COLS;
    wconv(win, DM, WIN_COLS, 0, 512, WINT, 0, DM, 0, sm, rot, G, bid, tid);
    wconv(win, DM, WIN_COLS, 768, 512, WINT, 512, DM, 0, sm, rot, G, bid, tid);
    wconv(win, DM, WIN_COLS, 2304, 768, WINT, 1024, DM, 0, sm, rot, G, bid, tid);
    wconv(win, DM, WIN_COLS, 512, 256, WINT, 1792, DM, 0, sm, rot, G, bid, tid);
    wconv(win, DM, WIN_COLS, 1280, 1024, WINT, 2048, DM, 0, sm, rot, G, bid, tid);
    wconv(win, DM, WIN_COLS, 3072, 288, WINT, 3072, DM, 0, sm, rot, G, bid, tid);
    wconv(win, DM, WIN_COLS, 3360, 3072, WINT, 3584, DM, 0, sm, rot, G, bid, tid);
    for (int i = bid * 512 + tid; i < 224 * DM / 8; i += G * 512) *(u32x4*)(WINT + (size_t)3360 * DM + (size_t)i * 8) = (u32x4){0u, 0u, 0u, 0u};
    bf16_t* WUKVT = (bf16_t*)(ws + WS_WUKVT);
    wconv(AIN(13) + (size_t)l * 256 * 512, 256, 512, 0, 512, WUKVT, 0, 256, 0, sm, rot, G, bid, tid);
    wconv(AIN(14) + (size_t)l * 256 * 512, 256, 512, 0, 512, WUKVT, 512, 256, 0, sm, rot, G, bid, tid);
    }
    if (groups & 2) {
    bf16_t* WO3T = (bf16_t*)(ws + WS_WO3T);
    wconv(AIN(15) + (size_t)l * 512 * DM, 512, DM, 0, DM, WO3T, 0, 1536, 0, sm, rot, G, bid, tid);
    wconv(AIN(16) + (size_t)l * 512 * DM, 512, DM, 0, DM, WO3T, 0, 1536, 512, sm, rot, G, bid, tid);
    wconv(AIN(17) + (size_t)l * 512 * DM, 512, DM, 0, DM, WO3T, 0, 1536, 1024, sm, rot, G, bid, tid);
    wconv(AIN(18) + (size_t)l * DM * DM, DM, DM, 0, DM, (bf16_t*)(ws + WS_WOUTT), 0, DM, 0, sm, rot, G, bid, tid);
    }
    if (groups & 4) {
    wconv(AIN(19) + (size_t)l * DM * DFF, DM, DFF, 0, DFF, (bf16_t*)(ws + WS_W1T), 0, DM, 0, sm, rot, G, bid, tid);
    wconv(AIN(20) + (size_t)l * DFF * DM, DFF, DM, 0, DM, (bf16_t*)(ws + WS_W2T), 0, DFF, 0, sm, rot, G, bid, tid);
    }
}

__device__ __forceinline__ void norm_mod(const float* xlat, const float* xctx, int nrows, const float* __restrict__ gain, const float* __restrict__ mod, int sh_i, int sc_i, bf16_t* H, int G, int bid, const int tid,
                                         const float* part = nullptr, int nparts = 0, float* xc_out = nullptr) {
    const int lane = tid & 63, wid = tid >> 6;
    for (int row0 = bid * 8 + wid; row0 < nrows; row0 += 2 * G * 8) {
        f32x4 v[2][4]; float ss[2] = {0.f, 0.f}; int rows[2]; bool ok[2];
#pragma unroll
        for (int j = 0; j < 2; ++j) { rows[j] = row0 + j * G * 8; ok[j] = rows[j] < nrows; const int row = ok[j] ? rows[j] : row0;
            const float* xr = row < NLAT ? xlat + (size_t)row * DM : xctx + (size_t)(row - NLAT) * DM;
#pragma unroll
            for (int i = 0; i < 4; ++i) v[j][i] = *(const f32x4*)(xr + lane * 4 + 256 * i); }
#pragma unroll
        for (int j = 0; j < 2; ++j) { const int row = ok[j] ? rows[j] : row0;
            if (nparts > 0 && row >= NLAT) {
                for (int p = 0; p < nparts; ++p) { const float* pr = part + ((size_t)p * NCTX + (row - NLAT)) * DM;
#pragma unroll
                    for (int i = 0; i < 4; ++i) v[j][i] += *(const f32x4*)(pr + lane * 4 + 256 * i); }
                if (xc_out && ok[j]) {
#pragma unroll
                    for (int i = 0; i < 4; ++i) *(f32x4*)(xc_out + (size_t)(row - NLAT) * DM + lane * 4 + 256 * i) = v[j][i]; }
            }
#pragma unroll
            for (int i = 0; i < 4; ++i) ss[j] += v[j][i][0] * v[j][i][0] + v[j][i][1] * v[j][i][1] + v[j][i][2] * v[j][i][2] + v[j][i][3] * v[j][i][3]; }
        ss[0] = wave_sum(ss[0]); ss[1] = wave_sum(ss[1]);
#pragma unroll
        for (int j = 0; j < 2; ++j) { if (!ok[j]) continue; const int row = rows[j];
            const float* mr = mod + (row < SEQ ? 0 : (row < NLAT ? 1 : 2)) * 6144;
            const float rstd = rsqrtf(ss[j] * (1.f / DM) + EPS);
#pragma unroll
            for (int i = 0; i < 4; ++i) { const int col = lane * 4 + 256 * i;
                const f32x4 g = *(const f32x4*)(gain + col), sh = *(const f32x4*)(mr + sh_i * DM + col), sc = *(const f32x4*)(mr + sc_i * DM + col);
                f32x4 h;
#pragma unroll
                for (int e = 0; e < 4; ++e) h[e] = (v[j][i][e] * rstd * g[e]) * (1.f + sc[e]) + sh[e];
                u32x2 w; w.x = pk2(h[0], h[1]); w.y = pk2(h[2], h[3]);
                *(u32x2*)(H + (size_t)row * DM + col) = w; } }
    }
}

__global__ void __launch_bounds__(512, 2) fwd(Args a) {
    extern __shared__ __attribute__((aligned(16))) unsigned char lds_raw[];
    LAS unsigned char* lds = (LAS unsigned char*)lds_raw;
    cg::grid_group grid = cg::this_grid();
    volatile LAS unsigned* xst = (volatile LAS unsigned*)(lds + LDS_BYTES - 16);
    if (threadIdx.x == 0) { xst[0] = 0u; xst[1] = 0u; }
    __syncthreads();
    (void)xcd_barrier_post((unsigned*)(a.ws + WS_BAR), xst);
    bool rep2 = false, need_sync = false;
    for (int ph = a.ph_lo; ph < a.ph_hi; ++ph) {
        if (need_sync) { if (a.ph_lo > NPH) { grid.sync(); }         else { XcdBarrier xb; xb.bar = (unsigned*)(a.ws + WS_BAR); xb.x = xb_xcc_id(); xb.st = (volatile LAS unsigned*)(lds + LDS_BYTES - 16); xcd_barrier(xb); } }
        need_sync = true;
        GAS unsigned char* wsg = (GAS unsigned char*)a.ws; asm volatile("" : "+s"(wsg));
        unsigned char* ws = (unsigned char*)wsg;
        int zofs = 0; asm volatile("" : "+s"(zofs));
        int G = gridDim.x, bid = blockIdx.x, tid = threadIdx.x; asm volatile("" : "+s"(G), "+s"(bid), "+v"(tid));
        const int lane = tid & 63, wid = __builtin_amdgcn_readfirstlane(tid >> 6);
        float* MOD = (float*)(ws + WS_MOD);
        f32x2* TABA = (f32x2*)(ws + WS_TABA); f32x2* TABM = (f32x2*)(ws + WS_TABM);
        float* XC = (float*)(ws + WS_XC);
        bf16_t* H = (bf16_t*)(ws + WS_H); bf16_t* PQ = (bf16_t*)(ws + WS_PQ); bf16_t* PKV = (bf16_t*)(ws + WS_PKV);
        bf16_t* CKV = (bf16_t*)(ws + WS_CKV); bf16_t* MLAKN = (bf16_t*)(ws + WS_MLAKN); bf16_t* MLAV = (bf16_t*)(ws + WS_MLAV); bf16_t* KR = (bf16_t*)(ws + WS_KR);
        bf16_t* GATES = (bf16_t*)(ws + WS_GATES); bf16_t* HID = (bf16_t*)(ws + WS_HID); float* PART = (float*)(ws + WS_CKV);
        const bf16_t* W1T = (const bf16_t*)(ws + WS_W1T); const bf16_t* W2T = (const bf16_t*)(ws + WS_W2T); const bf16_t* WINT = (const bf16_t*)(ws + WS_WINT);
        const bf16_t* WUKVT = (const bf16_t*)(ws + WS_WUKVT); const bf16_t* WO3T = (const bf16_t*)(ws + WS_WO3T); const bf16_t* WOUTT = (const bf16_t*)(ws + WS_WOUTT);

        if (ph == 0) {
            convert_weights(a, zofs, 0, (LAS float*)lds, G, bid, tid, G == 256 ? 3 : 7);
            for (int u = bid; u < 192; u += G) {
                const int l = u / 96, j0 = (u % 96) * 64;
                LAS float* sv = (LAS float*)lds; LAS float* red = sv + 3 * 1024;
                for (int i = tid; i < 3 * 1024; i += 512) { const int r = i >> 10, k = i & 1023; const float cv = r < 2 ? AIN(1)[r * DM + k] : AIN(3)[k]; sv[i] = cv / (1.f + __expf(-cv)); }
                __syncthreads();
                const int col = tid & 63, kq = tid >> 6;
                const float* wp = AIN(4) + (size_t)l * DM * 6144 + (size_t)(kq * 128) * 6144 + j0 + col;
                float a0 = 0.f, a1 = 0.f, a2 = 0.f;
#pragma unroll 8
                for (int k = 0; k < 128; ++k) { const float w = wp[(size_t)k * 6144]; a0 += sv[kq * 128 + k] * w; a1 += sv[1024 + kq * 128 + k] * w; a2 += sv[2048 + kq * 128 + k] * w; }
                red[(kq * 3 + 0) * 64 + col] = a0; red[(kq * 3 + 1) * 64 + col] = a1; red[(kq * 3 + 2) * 64 + col] = a2;
                __syncthreads();
                if (tid < 192) { const int r = tid >> 6, cl = tid & 63; float s = 0.f;
#pragma unroll
                    for (int q = 0; q < 8; ++q) s += red[(q * 3 + r) * 64 + cl];
                    MOD[(l * 3 + r) * 6144 + j0 + cl] = s + AIN(5)[l * 6144 + j0 + cl]; }
                __syncthreads();
            }
            for (int i = bid * 512 + tid; i < SEQ * 48; i += G * 512) {
                const int t = i / 48, f = i - t * 48; const float rowf = (float)(t >> 6), colf = (float)(t & 63);
                if (f < 32) { const int fi = f & 15; const float inv = __builtin_amdgcn_exp2f(-(float)(2 * fi) * (13.287712379549449f / 32.f)); const float ang = (f < 16 ? rowf : colf) * inv; TABA[t * 32 + f] = (f32x2){__cosf(ang), __sinf(ang)}; }
                else { const int f2 = f - 32, fi = f2 & 7; const float inv = __builtin_amdgcn_exp2f(-(float)(2 * fi) * (13.287712379549449f / 16.f)); const float ang = (f2 < 8 ? rowf : colf) * inv; TABM[t * 16 + f2] = (f32x2){__cosf(ang), __sinf(ang)}; }
            }
        } else if (ph == NPH - 1) {
            const float* fg = AIN(21);
            for (int row = bid * 8 + wid; row < NLAT; row += G * 8) {
                float* xr = a.out + (size_t)row * DM; f32x4 v[4]; float ss = 0.f;
#pragma unroll
                for (int i = 0; i < 4; ++i) { v[i] = *(const f32x4*)(xr + lane * 4 + 256 * i); ss += v[i][0] * v[i][0] + v[i][1] * v[i][1] + v[i][2] * v[i][2] + v[i][3] * v[i][3]; }
                ss = wave_sum(ss); const float rstd = rsqrtf(ss * (1.f / DM) + EPS);
#pragma unroll
                for (int i = 0; i < 4; ++i) { const f32x4 g = *(const f32x4*)(fg + lane * 4 + 256 * i); *(f32x4*)(xr + lane * 4 + 256 * i) = v[i] * rstd * g; }
            }
        } else {
            const int l = (ph - 1) / 11, sp = (ph - 1) % 11;
            const float* modl = MOD + l * 3 * 6144;
            const int nMfull = 66, nMpost = (l == 0) ? 66 : 64;
            const float* xlat_in = (l == 0) ? AIN(0) : a.out; const float* xctx_in = (l == 0) ? AIN(2) : XC;
            if (sp == 0) {
                if (l == 1) { if (G == 256) {} else if (G >= 64) convert_weights(a, zofs, 1, (LAS float*)lds, G, bid, tid, 4); else convert_weights(a, zofs, 1, (LAS float*)lds, G, bid, tid, 7); }
                norm_mod(xlat_in, xctx_in, MP, AIN(6) + l * DM, modl, 0, 1, H, G, bid, tid, PART, l == 1 ? 8 : 0, nullptr);
            } else if (sp == 1) {
                pg8::TileSched S; S.init(nMfull, 14, G, bid, H, DM, WINT, DM, DM);
                pg8::Epi<pg8::EK_QKV> E{}; E.o0 = PQ; E.o1 = PKV;
                pg8::gemm_phase(tid, lds, DM, DM, S, E);
                { int G2 = gridDim.x, b2 = blockIdx.x, t2 = threadIdx.x, z2 = 0; asm volatile("" : "+s"(G2), "+s"(b2), "+v"(t2), "+s"(z2));
                  if (G2 == 256 && b2 >= 156) convert_weights(a, z2, l, (LAS float*)lds, 100, b2 - 156, t2, 4); }
            } else if (sp == 2) {
                const float* qn = AIN(9) + l * 64; const float* kn = AIN(10) + l * 64; const float* kvn = AIN(12) + l * 256;
                const int l8 = lane & 7;
                for (int row = bid * 8 + wid; row < MP; row += G * 8) {
                    const bool lat = row < NLAT; const int t = row & (SEQ - 1);
                    bf16_t* pq = PQ + (size_t)row * PQ_LD; bf16_t* pkv = PKV + (size_t)row * PKV_LD;
                    f32x2 csa[8];
                    { const f32x4* tp = (const f32x4*)(TABA + (size_t)t * 32 + ((lane >> 2) & 1) * 16 + (lane & 1) * 8);
#pragma unroll
                      for (int e = 0; e < 4; ++e) { const f32x4 c2 = lat ? tp[e] : (f32x4){1.f, 0.f, 1.f, 0.f}; csa[2 * e] = (f32x2){c2[0], c2[1]}; csa[2 * e + 1] = (f32x2){c2[2], c2[3]}; } }
#pragma unroll
                    for (int pass = 0; pass < 2; ++pass) {
                        bf16_t* p = pass == 0 ? pq + lane * 8 : pkv + (lane & 15) * 8;
                        const float* gp = (pass == 0 ? qn : kn) + l8 * 8;
                        const u32x4 w = *(const u32x4*)p; const f32x4 g0 = *(const f32x4*)gp, g1 = *(const f32x4*)(gp + 4);
                        float v[8] = {bflo(w.x), bfhi(w.x), bflo(w.y), bfhi(w.y), bflo(w.z), bfhi(w.z), bflo(w.w), bfhi(w.w)};
                        float ss = 0.f;
#pragma unroll
                        for (int e = 0; e < 8; ++e) ss += v[e] * v[e];
                        ss += __int_as_float(__builtin_amdgcn_update_dpp(0, __float_as_int(ss), 0xB1, 0xf, 0xf, true));
                        ss += __int_as_float(__builtin_amdgcn_update_dpp(0, __float_as_int(ss), 0x4E, 0xf, 0xf, true));
                        ss += __int_as_float(__builtin_amdgcn_update_dpp(0, __float_as_int(ss), 0x141, 0xf, 0xf, true));
                        const float rstd = rsqrtf(ss * (1.f / 64.f) + EPS);
                        float o[8];
#pragma unroll
                        for (int e = 0; e < 8; ++e) { const float y = v[e] * rstd * (e < 4 ? g0[e & 3] : g1[e & 3]);
                            const float pr = __int_as_float(__builtin_amdgcn_update_dpp(0, __float_as_int(y), 0x4E, 0xf, 0xf, true));
                            o[e] = (lane & 2) ? y * csa[e][0] + pr * csa[e][1] : y * csa[e][0] - pr * csa[e][1]; }
                        u32x4 ow; ow.x = pk2(o[0], o[1]); ow.y = pk2(o[2], o[3]); ow.z = pk2(o[4], o[5]); ow.w = pk2(o[6], o[7]);
                        if (pass == 0 || lane < 16) *(u32x4*)p = ow;
                    }
                    f32x2 csm[4];
                    { const f32x4* tp = (const f32x4*)(TABM + (size_t)t * 16 + (l8 >> 2) * 8 + (l8 & 1) * 4);
#pragma unroll
                      for (int e = 0; e < 2; ++e) { const f32x4 c2 = lat ? tp[e] : (f32x4){1.f, 0.f, 1.f, 0.f}; csm[2 * e] = (f32x2){c2[0], c2[1]}; csm[2 * e + 1] = (f32x2){c2[2], c2[3]}; } }
#pragma unroll
                    for (int pass = 0; pass < 2; ++pass) {
                        bf16_t* p = pass == 0 ? pq + 1536 + (lane >> 3) * 96 + 64 + l8 * 4 : pkv + 1536 + l8 * 4;
                        const u32x2 w = *(const u32x2*)p; const float v[4] = {bflo(w.x), bfhi(w.x), bflo(w.y), bfhi(w.y)}; float o[4];
#pragma unroll
                        for (int e = 0; e < 4; ++e) { const float pr = __int_as_float(__builtin_amdgcn_update_dpp(0, __float_as_int(v[e]), 0x4E, 0xf, 0xf, true));
                            o[e] = (lane & 2) ? v[e] * csm[e][0] + pr * csm[e][1] : v[e] * csm[e][0] - pr * csm[e][1]; }
                        u32x2 ow; ow.x = pk2(o[0], o[1]); ow.y = pk2(o[2], o[3]);
                        if (pass == 0) *(u32x2*)p = ow; else if (lane < 8) *(u32x2*)(KR + (size_t)row * 32 + l8 * 4) = ow;
                    }
                    { const u32x2 w = *(const u32x2*)(pkv + 1280 + lane * 4); const float v0 = bflo(w.x), v1 = bfhi(w.x), v2 = bflo(w.y), v3 = bfhi(w.y);
                      const float ss = wave_sum(v0 * v0 + v1 * v1 + v2 * v2 + v3 * v3); const float rstd = rsqrtf(ss * (1.f / 256.f) + EPS);
                      const f32x4 g = *(const f32x4*)(kvn + lane * 4); u32x2 o; o.x = pk2(v0 * rstd * g[0], v1 * rstd * g[1]); o.y = pk2(v2 * rstd * g[2], v3 * rstd * g[3]);
                      *(u32x2*)(CKV + (size_t)row * 256 + lane * 4) = o; }
                }
            } else if (sp == 3) {
                pg8::TileSched S; S.init(nMfull, 4, G, bid, CKV, 256, WUKVT, 256, 256);
                pg8::Epi<pg8::EK_UKV> E{}; E.o0 = MLAKN; E.o1 = MLAV;
                pg8::gemm_phase(tid, lds, 256, 256, S, E);
            } else if (sp == 4) {
                const int total = 1536 + (l == 0 ? 48 : 0);
                const float c64 = 0.125f * LOG2E, c96 = 0.10206207261596577f * LOG2E;
                bool gqa_nomax; { float gqm = 0.f, gkm = 0.f; const float* qn_ = AIN(9) + l * 64; const float* kn_ = AIN(10) + l * 64;
                    for (int i = 0; i < 64; ++i) { gqm = fmaxf(gqm, fabsf(qn_[i])); gkm = fmaxf(gkm, fabsf(kn_[i])); }
                    gqa_nomax = (11.8f * gqm * gkm < 40.f); }
                for (int u = (DUPMASK && rep2) ? 512 + bid : bid; u < ((DUPMASK && rep2) ? 1024 : total); u += G) {
                    int tidu = tid; asm volatile("" : "+v"(tidu));
                    if (u < 512) {
                        const int xcd = u & 7, within = u >> 3, combo = xcd >> 1, b = combo >> 1, kvh = combo & 1, sub = (xcd & 1) * 64 + within, h = kvh * 4 + (sub >> 5), qb = sub & 31;
                        bf16_t* qp = PQ + ((size_t)b * SEQ + qb * 256) * PQ_LD + h * 64;
                        attn_unit<64, false>(tidu, lds, qp, qp, PKV + kvh * 64, PKV + 128 + kvh * 64, nullptr, b * SEQ, NLAT + b * CTXL, 128, c64, nullptr, 0, 0, gqa_nomax);
                    } else if (u < 1024) {
                        const int idx = u - 512, xcd = idx & 7, within = idx >> 3, combo = xcd * 2 + (within >> 5), b = combo >> 3, h = combo & 7, qb = within & 31;
                        bf16_t* qp = PQ + ((size_t)b * SEQ + qb * 256) * PQ_LD;
                        attn_unit<96, false>(tidu, lds, qp + 1536 + h * 96, qp + 1024 + h * 64, MLAKN + h * 64, MLAV + h * 64, KR, b * SEQ, NLAT + b * CTXL, 128, c96, nullptr, 0, 0);
                    } else if (u < 1536) {
                        const int idx = u - 1024, h = idx & 7, within = idx >> 3, b = within >> 5, rg = within & 31;
                        const int r0 = rg * 4, rs0 = min(max(r0 - 4, 0), 120), rse = min(max(r0 - 1, 0), 120) + 8;
                        bf16_t* qp = PQ + ((size_t)b * SEQ + rg * 256) * PQ_LD + 512 + h * 64;
                        attn_unit<64, true>(tidu, lds, qp, qp, PKV + 256 + h * 64, PKV + 768 + h * 64, nullptr, b * SEQ + rs0 * 64, NLAT + b * CTXL, rse - rs0, c64,
                                            AIN(11) + (size_t)(l * 8 + h) * 465, r0, rs0);
                    } else {
                        const int j = u - 1536, ty = j >> 4, b = (j >> 3) & 1, h = j & 7;
                        const int rowc = NLAT + b * CTXL;
                        bf16_t* qp = PQ + (size_t)rowc * PQ_LD;
                        if (ty == 0) { const int kvh = h >> 2;
                            attn_unit<64, false>(tidu, lds, qp + h * 64, qp + h * 64, PKV + kvh * 64, PKV + 128 + kvh * 64, nullptr, 0, rowc, 0, c64, nullptr, 0, 0);
                        } else if (ty == 1) {
                            attn_unit<64, false>(tidu, lds, qp + 512 + h * 64, qp + 512 + h * 64, PKV + 256 + h * 64, PKV + 768 + h * 64, nullptr, 0, rowc, 0, c64, nullptr, 0, 0);
                        } else {
                            attn_unit<96, false>(tidu, lds, qp + 1536 + h * 96, qp + 1024 + h * 64, MLAKN + h * 64, MLAV + h * 64, KR, 0, rowc, 0, c96, nullptr, 0, 0);
                        }
                    }
                }
            } else if (sp == 5) {
                pg8::TileSched S; S.init(nMpost, 12, G, bid, H, DM, WINT + (size_t)3584 * DM, DM, DM);
                pg8::Epi<pg8::EK_GATE> E{}; E.o0 = GATES;
                pg8::gemm_phase(tid, lds, DM, DM, S, E);
            } else if (sp == 6) {
                pg8::TileSched S; S.init(nMpost, 4, G, bid, PQ, PQ_LD, WO3T, 1536, 1536);
                pg8::Epi<pg8::EK_MERGE> E{}; E.o0 = H; E.gates = GATES;
                pg8::gemm_phase(tid, lds, PQ_LD, 1536, S, E);
                if (l == 0) { int G2 = gridDim.x, b2 = blockIdx.x, t2 = threadIdx.x, z2 = 0; asm volatile("" : "+s"(G2), "+s"(b2), "+v"(t2), "+s"(z2));
                    if (G2 >= 64 && b2 >= 8) convert_weights(a, z2, 1, (LAS float*)lds, G2 - 8, b2 - 8, t2, 1); }
            } else if (sp == 7) {
                pg8::TileSched S; S.init(64, 4, G, bid, H, DM, WOUTT, DM, DM); if (l == 0) S.split_ctx(4);
                pg8::Epi<pg8::EK_RES> E{}; E.xin_lat = xlat_in; E.xin_ctx = xctx_in; E.xout_lat = a.out; E.xout_ctx = XC; E.gmod = modl + 2 * DM; E.part = PART;
                pg8::gemm_phase(tid, lds, DM, DM, S, E);
            } else if (sp == 8) {
                norm_mod(a.out, l == 0 ? AIN(2) : XC, nMpost * 256, AIN(7) + l * DM, modl, 3, 4, H, G, bid, tid, PART, l == 0 ? 4 : 0, XC);
            } else if (sp == 9) {
                pg8::TileSched S; S.init(nMpost, 16, G, bid, H, DM, W1T, DM, DM);
                pg8::Epi<pg8::EK_SQRELU> E{}; E.o0 = HID;
                pg8::gemm_phase(tid, lds, DM, DM, S, E);
                if (l == 0) { int G2 = gridDim.x, b2 = blockIdx.x, t2 = threadIdx.x, z2 = 0; asm volatile("" : "+s"(G2), "+s"(b2), "+v"(t2), "+s"(z2));
                    if (G2 >= 64 && b2 >= 32) convert_weights(a, z2, 1, (LAS float*)lds, G2 - 32, b2 - 32, t2, 2); }
            } else {
                pg8::TileSched S; S.init(64, 4, G, bid, HID, DFF, W2T, DFF, DFF); if (l == 0) S.split_ctx(8);
                pg8::Epi<pg8::EK_RES> E{}; E.xin_lat = a.out; E.xin_ctx = XC; E.xout_lat = a.out; E.xout_ctx = XC; E.gmod = modl + 5 * DM; E.part = PART;
                pg8::gemm_phase(tid, lds, DFF, DFF, S, E);
            }
        }
        if (DUPMASK) {
            bool dup = false;
            if (ph == 0) dup = (DUPMASK & 1);
            else if (ph < NPH - 1) { const int l_ = (ph - 1) / 11, sp_ = (ph - 1) % 11; dup = ((DUPMASK >> (1 + sp_)) & 1) && sp_ != 2 && sp_ != 10 && !(sp_ == 7 && l_ == 1); }
            if (dup && !rep2) { rep2 = true; --ph; } else rep2 = false;
        }
    }
}

extern "C" void kernel_launch(void* const* d_in, const int* in_sizes, int n_in, void* d_out, int out_size, void* d_ws, size_t ws_size, hipStream_t stream) {
    static int grid = 0;
    if (grid == 0) {
        if (n_in != 22 || ws_size < WS_END) { fprintf(stderr, "kernel_launch: unexpected n_in %d / ws %zu\n", n_in, ws_size); grid = -1; return; }
        int dev = 0, cus = 0, per_cu = 0;
        hipGetDevice(&dev); hipDeviceGetAttribute(&cus, hipDeviceAttributeMultiprocessorCount, dev);
        if (hipFuncSetAttribute((const void*)fwd, hipFuncAttributeMaxDynamicSharedMemorySize, LDS_BYTES) != hipSuccess) { fprintf(stderr, "kernel_launch: hipFuncSetAttribute failed\n"); grid = -1; return; }
        if (hipOccupancyMaxActiveBlocksPerMultiprocessor(&per_cu, (const void*)fwd, 512, LDS_BYTES) != hipSuccess || per_cu < 1) { fprintf(stderr, "kernel_launch: occupancy query gave %d\n", per_cu); per_cu = 1; }
        (void)hipGetLastError();
        grid = cus * 1;
    }
    if (grid < 0) return;
    if (hipMemsetAsync((char*)d_ws + WS_BAR, 0, XCD_BAR_WORDS * 4, stream) != hipSuccess) { fprintf(stderr, "kernel_launch: memset of the barrier words failed\n"); return; }
    Args a{};
    for (int i = 0; i < 22; ++i) a.in[i] = (const float*)d_in[i];
    a.out = (float*)d_out; a.ws = (unsigned char*)d_ws;
#if N_LAUNCH_MODE == 1
    a.ph_lo = 0; a.ph_hi = NPH;
    void* args[] = {&a};
    hipError_t e = hipLaunchCooperativeKernel((const void*)fwd, dim3(grid), dim3(512), args, LDS_BYTES, stream);
    if (e != hipSuccess) fprintf(stderr, "cooperative launch failed: %s (grid %d)\n", hipGetErrorString(e), grid);
#else
    for (int ph = 0; ph < NPH; ++ph) { a.ph_lo = ph; a.ph_hi = ph + 1; hipLaunchKernelGGL(fwd, dim3(grid), dim3(512), LDS_BYTES, stream, a); }
#endif
}
```

```cpp
#include <hip/hip_runtime.h>
#include <hip/hip_cooperative_groups.h>
#include <cstdio>
#include <cstdint>
namespace cg = cooperative_groups;

#ifndef DUPMASK
#define DUPMASK 0
#endif
#ifndef N_LAUNCH_MODE
#define N_LAUNCH_MODE 1
#endif

#define LAS __attribute__((address_space(3)))
#define GAS __attribute__((address_space(1)))
typedef unsigned short bf16_t;
typedef short bf16x8 __attribute__((ext_vector_type(8)));
typedef short s16x4 __attribute__((ext_vector_type(4)));
typedef float f32x2 __attribute__((ext_vector_type(2)));
typedef float f32x4 __attribute__((ext_vector_type(4)));
typedef float f32x16 __attribute__((ext_vector_type(16)));
typedef unsigned u32x2 __attribute__((ext_vector_type(2)));
typedef unsigned u32x4 __attribute__((ext_vector_type(4)));
typedef __bf16 bf16x2_t __attribute__((ext_vector_type(2)));

constexpr int DM = 1024, SEQ = 8192, NLAT = 16384, CTXL = 256, NCTX = 512, MP = 16896, DFF = 4096;
constexpr int WIN_COLS = 6432;
constexpr int PQ_LD = 2304, PKV_LD = 1792, GATE_LD = 3072;
constexpr float EPS = 1e-6f;
constexpr float LOG2E = 1.4426950408889634f;
constexpr int NPH = 24;

constexpr size_t KiB = 1024, MiB = 1u << 20;
constexpr size_t WS_MOD = 0;
constexpr size_t WS_BAR = 512 * KiB;
constexpr size_t WS_TABA = 1 * MiB;
constexpr size_t WS_TABM = 3 * MiB;
constexpr size_t WS_XC = 4 * MiB;
constexpr size_t WS_W1T = 6 * MiB, WS_W2T = 14 * MiB, WS_WINT = 22 * MiB, WS_WUKVT = 35 * MiB, WS_WO3T = 35 * MiB + 512 * KiB, WS_WOUTT = 38 * MiB + 512 * KiB;
constexpr size_t WS_H = 40 * MiB + 512 * KiB;
constexpr size_t WS_PQ = WS_H + (size_t)MP * 1024 * 2;
constexpr size_t WS_PKV = WS_PQ + (size_t)MP * PQ_LD * 2;
constexpr size_t WS_CKV = WS_PKV + (size_t)MP * PKV_LD * 2;
constexpr size_t WS_MLAKN = WS_CKV + (size_t)MP * 256 * 2;
constexpr size_t WS_MLAV = WS_MLAKN + (size_t)MP * 512 * 2;
constexpr size_t WS_KR = WS_MLAV + (size_t)MP * 512 * 2;
constexpr size_t WS_END = WS_KR + (size_t)MP * 32 * 2;
constexpr size_t WS_GATES = WS_PKV;
constexpr size_t WS_HID = WS_PQ;
static_assert(WS_GATES + (size_t)MP * GATE_LD * 2 <= WS_KR, "gates overlay");
static_assert(WS_HID + (size_t)MP * DFF * 2 <= WS_END, "hid overlay");
static_assert(WS_END <= 256 * MiB, "workspace");

constexpr int LDS_BYTES = 147456;

__device__ __forceinline__ float bf2f(bf16_t v) { return __uint_as_float(((unsigned)v) << 16); }
__device__ __forceinline__ float bflo(unsigned w) { return __uint_as_float(w << 16); }
__device__ __forceinline__ float bfhi(unsigned w) { return __uint_as_float(w & 0xffff0000u); }
__device__ __forceinline__ unsigned pk2(float lo, float hi) { f32x2 v = {lo, hi}; bf16x2_t b = __builtin_convertvector(v, bf16x2_t); return __builtin_bit_cast(unsigned, b); }
__device__ __forceinline__ bf16_t f2bf(float f) { return (bf16_t)(pk2(f, 0.f) & 0xffffu); }
__device__ __forceinline__ float wave_sum(float v) {
    v += __int_as_float(__builtin_amdgcn_update_dpp(0, __float_as_int(v), 0xB1, 0xf, 0xf, true));
    v += __int_as_float(__builtin_amdgcn_update_dpp(0, __float_as_int(v), 0x4E, 0xf, 0xf, true));
    v += __int_as_float(__builtin_amdgcn_update_dpp(0, __float_as_int(v), 0x141, 0xf, 0xf, true));
    v += __int_as_float(__builtin_amdgcn_update_dpp(0, __float_as_int(v), 0x140, 0xf, 0xf, true));
    const float s0 = __int_as_float(__builtin_amdgcn_readlane(__float_as_int(v), 0)), s1 = __int_as_float(__builtin_amdgcn_readlane(__float_as_int(v), 16));
    const float s2 = __int_as_float(__builtin_amdgcn_readlane(__float_as_int(v), 32)), s3 = __int_as_float(__builtin_amdgcn_readlane(__float_as_int(v), 48));
    return (s0 + s1) + (s2 + s3);
}
__device__ __forceinline__ float swap_max(float m) { auto rr = __builtin_amdgcn_permlane32_swap(__float_as_uint(m), __float_as_uint(m), false, false); return fmaxf(__uint_as_float(rr[0]), __uint_as_float(rr[1])); }
__device__ __forceinline__ float swap_sum(float m) { auto rr = __builtin_amdgcn_permlane32_swap(__float_as_uint(m), __float_as_uint(m), false, false); return __uint_as_float(rr[0]) + __uint_as_float(rr[1]); }
__device__ __forceinline__ float fast_sigmoid(float x) { return fmaxf(__builtin_amdgcn_rcpf(1.f + __builtin_amdgcn_exp2f(-x * LOG2E)), 1e-30f); }

namespace pg8 {
constexpr int BM = 256, BK = 64, HALF = 128, HTB = HALF * BK * 2, STAGE_BYTES = 8 * HTB, NXCD = 8, WGM = 8;
__device__ __forceinline__ int lds_byte(int r, int c) { const int st = (r >> 4) * 2 + (c >> 5), rr = r & 15, cc = c & 31, ob = rr * 64 + cc * 2; return st * 1024 + (ob ^ (((ob >> 9) & 1) << 5)); }
__device__ __forceinline__ void stage_rc(int b, int& R, int& C) { const int st = b / 1024, sb = b % 1024, swz = sb ^ (((sb >> 9) & 1) << 5); R = (st >> 1) * 16 + swz / 64; C = (st & 1) * 32 + (swz % 64) / 2; }
__device__ __forceinline__ int perm32(int rho) { const int n = rho >> 4, i = rho & 15; return 8 * (i >> 2) + 4 * n + (i & 3); }

struct Unit { const char* a; const char* b; int nt; int kind; int pm; int pn; };

template <class Epi, class Sched>
__device__ __forceinline__ void gemm_phase(const int tid, LAS unsigned char* lds, const int lda, const int ldb, const Sched& S, const Epi& E) {
    const int wid = __builtin_amdgcn_readfirstlane(tid >> 6), lane = tid & 63, wr = wid >> 2, wc = wid & 3, fr = lane & 15, fq = lane >> 4;
    unsigned voffA[2], voffB[2];
#pragma unroll
    for (int i = 0; i < 2; ++i) { int R, C; stage_rc(tid * 16 + i * 8192, R, C); const int Rb = (R & ~31) + perm32(R & 31);
        voffA[i] = (unsigned)(R * lda + C) * 2u; voffB[i] = (unsigned)(Rb * ldb + C) * 2u; }
    const size_t kstep = (size_t)(BK * 2);
    const size_t hstepA = (size_t)HALF * lda * 2, hstepB = (size_t)HALF * ldb * 2;
    const unsigned ldsw = (unsigned)wid * 1024u;
    const int aoff = lds_byte(wr * 64 + fr, fq * 8), boff = lds_byte(wc * 32 + fr, fq * 8);
#define PG8_SA(b, h) (((b) * 2 + (h)) * HTB)
#define PG8_SB(b, h) ((4 + (b) * 2 + (h)) * HTB)
#define PG8_STAGE(bufoff, gbase, voff) do { _Pragma("unroll") for (int _i = 0; _i < 2; ++_i) \
        __builtin_amdgcn_global_load_lds((const unsigned*)((const char*)(gbase) + (voff)[_i]), (LAS unsigned*)(lds + (bufoff) + ldsw + _i * 8192), 16, 0, 0); } while (0)
#define PG8_LDA(dst, b, h) do { _Pragma("unroll") for (int m = 0; m < 4; ++m) _Pragma("unroll") for (int k = 0; k < 2; ++k) dst[m][k] = *(const LAS bf16x8*)(lds + PG8_SA(b, h) + aoff + m * 2048 + k * 1024); } while (0)
#define PG8_LDB(dst, b, h) do { _Pragma("unroll") for (int n = 0; n < 2; ++n) _Pragma("unroll") for (int k = 0; k < 2; ++k) dst[n][k] = *(const LAS bf16x8*)(lds + PG8_SB(b, h) + boff + n * 2048 + k * 1024); } while (0)
#define PG8_MMA(ai, bj, At, Bt) do { __builtin_amdgcn_s_setprio(1); _Pragma("unroll") for (int m = 0; m < 4; ++m) _Pragma("unroll") for (int n = 0; n < 2; ++n) _Pragma("unroll") for (int k = 0; k < 2; ++k) \
        acc[ai][bj][m][n] = __builtin_amdgcn_mfma_f32_16x16x32_bf16(Bt[n][k], At[m][k], acc[ai][bj][m][n], 0, 0, 0); __builtin_amdgcn_s_setprio(0); } while (0)
#define PG8_WAIT_V(n) asm volatile("s_waitcnt vmcnt(" #n ")" ::: "memory")
#define PG8_WAIT_L(n) asm volatile("s_waitcnt lgkmcnt(" #n ")" ::: "memory")
#define PG8_BAR __builtin_amdgcn_s_barrier()
#define PG8_SCHED __builtin_amdgcn_sched_barrier(0)
    Unit cur, nxt; int ui = 0;
    if (!S.next(0, cur)) return;
    f32x4 acc[2][2][4][2];
#pragma unroll
    for (int a = 0; a < 2; ++a)
#pragma unroll
        for (int b = 0; b < 2; ++b)
#pragma unroll
            for (int m = 0; m < 4; ++m)
#pragma unroll
                for (int n = 0; n < 2; ++n) acc[a][b][m][n] = (f32x4){0.f, 0.f, 0.f, 0.f};
    bf16x8 At[4][2], B0[2][2], B1[2][2];
    const char* cA = cur.a; const char* cB = cur.b;
    PG8_STAGE(PG8_SB(0, 0), cB, voffB); PG8_STAGE(PG8_SB(0, 1), cB + hstepB, voffB); PG8_STAGE(PG8_SA(0, 0), cA, voffA); PG8_STAGE(PG8_SA(0, 1), cA + hstepA, voffA);
    if (wr == 1) PG8_BAR;
    PG8_WAIT_V(2); PG8_BAR;
    PG8_STAGE(PG8_SB(1, 0), cB + kstep, voffB); PG8_STAGE(PG8_SA(1, 0), cA + kstep, voffA); PG8_STAGE(PG8_SB(1, 1), cB + hstepB + kstep, voffB);
    PG8_WAIT_V(6); PG8_BAR;
    for (;;) {
        const bool has_next = S.next(ui + 1, nxt);
        const char* nA = has_next ? nxt.a : cA; const char* nB = has_next ? nxt.b : cB;
        const int nt = cur.nt;
        for (int t = 0; t < nt; t += 2) {
            if constexpr (Epi::HOOK) { if (t == 8 || t == 16) { if (wr == 0) PG8_BAR; E.hook(acc, cur, (t >> 3) - 1, wr, wc, fr, fq); if (wr == 1) PG8_BAR; } }
            const bool last = (t == nt - 2);
            const char* a1 = cA + (size_t)(t + 1) * kstep;
            const char* a2 = last ? nA : cA + (size_t)(t + 2) * kstep; const char* b2 = last ? nB : cB + (size_t)(t + 2) * kstep;
            const char* a3 = a2 + kstep; const char* b3 = b2 + kstep;
            PG8_LDB(B0, 0, 0); PG8_LDB(B1, 0, 1); PG8_SCHED; PG8_LDA(At, 0, 0); PG8_STAGE(PG8_SA(1, 1), a1 + hstepA, voffA);
            PG8_WAIT_V(8); PG8_WAIT_L(0); PG8_BAR; PG8_MMA(0, 0, At, B0); PG8_MMA(0, 1, At, B1); PG8_BAR; PG8_SCHED;
            PG8_LDA(At, 0, 1); PG8_STAGE(PG8_SB(0, 0), b2, voffB); PG8_STAGE(PG8_SB(0, 1), b2 + hstepB, voffB); PG8_STAGE(PG8_SA(0, 0), a2, voffA);
            PG8_WAIT_V(8); PG8_WAIT_L(0); PG8_BAR; PG8_MMA(1, 0, At, B0); PG8_MMA(1, 1, At, B1); PG8_BAR; PG8_SCHED;
            PG8_LDB(B0, 1, 0); PG8_LDB(B1, 1, 1); PG8_SCHED; PG8_LDA(At, 1, 0); PG8_STAGE(PG8_SA(0, 1), a2 + hstepA, voffA);
            PG8_WAIT_V(8); PG8_WAIT_L(0); PG8_BAR; PG8_MMA(0, 0, At, B0); PG8_MMA(0, 1, At, B1); PG8_BAR; PG8_SCHED;
            PG8_LDA(At, 1, 1); PG8_STAGE(PG8_SB(1, 0), b3, voffB); PG8_STAGE(PG8_SB(1, 1), b3 + hstepB, voffB); PG8_STAGE(PG8_SA(1, 0), a3, voffA);
            PG8_WAIT_V(8); PG8_WAIT_L(0); PG8_BAR; PG8_MMA(1, 0, At, B0); PG8_MMA(1, 1, At, B1); PG8_BAR; PG8_SCHED;
        }
        if (wr == 0) PG8_BAR;
        E(acc, cur, wr, wc, fr, fq);
        if (!has_next) break;
#pragma unroll
        for (int a = 0; a < 2; ++a)
#pragma unroll
            for (int b = 0; b < 2; ++b)
#pragma unroll
                for (int m = 0; m < 4; ++m)
#pragma unroll
                    for (int n = 0; n < 2; ++n) acc[a][b][m][n] = (f32x4){0.f, 0.f, 0.f, 0.f};
        cur = nxt; cA = nA; cB = nB; ++ui;
        if (wr == 1) PG8_BAR;
    }
    PG8_WAIT_V(0);
    PG8_BAR;
#undef PG8_SA
#undef PG8_SB
#undef PG8_STAGE
#undef PG8_LDA
#undef PG8_LDB
#undef PG8_MMA
#undef PG8_WAIT_V
#undef PG8_WAIT_L
#undef PG8_BAR
#undef PG8_SCHED
}

struct TileSched {
    int nM, nN, nwg, G, c; const char* A; const char* Bt; size_t atile, btile; int nt;
    int nchunk = 0, nlat_mine = 0;
    __device__ __forceinline__ void init(int nM_, int nN_, int G_, int c_, const void* A_, int lda, const void* Bt_, int ldb, int K) {
        nM = nM_; nN = nN_; nwg = nM * nN; G = G_; c = c_; A = (const char*)A_; Bt = (const char*)Bt_; atile = (size_t)BM * lda * 2; btile = (size_t)BM * ldb * 2; nt = K / BK; }
    __device__ __forceinline__ void split_ctx(int nchunk_) { nchunk = nchunk_; nlat_mine = c < nwg ? (nwg - c + G - 1) / G : 0; }
    __device__ __forceinline__ bool next(int i, Unit& u) const {
        if (nchunk > 0 && i >= nlat_mine) {
            const long s = (long)(i - nlat_mine) * G + c; if (s >= 2 * nN * nchunk) return false;
            const int chunk = (int)s % nchunk, up = (int)s / nchunk, ntc = nt / nchunk;
            u.pm = 64 + up / nN; u.pn = up % nN; u.nt = ntc; u.kind = 1 + chunk;
            u.a = A + (size_t)u.pm * atile + (size_t)chunk * ntc * (BK * 2); u.b = Bt + (size_t)u.pn * btile + (size_t)chunk * ntc * (BK * 2); return true;
        }
        const long L = (long)i * G + c; if (L >= nwg) return false;
        int wgid = (int)L; { const int q = nwg / NXCD, r = nwg % NXCD, xcd = wgid % NXCD, off = wgid / NXCD; wgid = (xcd < r ? xcd * (q + 1) : r * (q + 1) + (xcd - r) * q) + off; }
        const int nig = WGM * nN, gid = wgid / nig, fm = gid * WGM, gsz = (nM - fm) < WGM ? (nM - fm) : WGM;
        u.pm = fm + ((wgid % nig) % gsz); u.pn = (wgid % nig) / gsz;
        u.a = A + (size_t)u.pm * atile; u.b = Bt + (size_t)u.pn * btile; u.nt = nt; u.kind = 0; return true;
    }
};
__device__ __forceinline__ size_t gate_tile(int br, int pm, int pn) { return ((size_t)((br * 66 + pm) * 4 + pn)) * 65536; }
enum { EK_QKV = 0, EK_UKV, EK_GATE, EK_MERGE, EK_RES, EK_SQRELU };
template <int EK> struct Epi {
    bf16_t* o0; bf16_t* o1;
    const bf16_t* gates;
    const float* xin_lat; const float* xin_ctx; float* xout_lat; float* xout_ctx; const float* gmod; float* part;
    static constexpr bool HOOK = (EK == EK_MERGE);
    __device__ __forceinline__ void hook(f32x4 (&acc)[2][2][4][2], const Unit& u, const int seg, int wr, int wc, int fr, int fq) const {
        const int tid8 = (((wr * 4 + wc) * 64) + fq * 16 + fr) * 8;
        const GAS bf16_t* gp = (const GAS bf16_t*)gates + gate_tile(seg, u.pm, u.pn) + tid8;
        constexpr size_t NEXT = (size_t)66 * 4 * 65536;
#pragma unroll
        for (int ai = 0; ai < 2; ++ai) {
            asm volatile("" : "+v"(gp));
#pragma unroll
            for (int m = 0; m < 4; ++m) {
#pragma unroll
                for (int bj = 0; bj < 2; ++bj) {
                    const u32x4 ga = *(const GAS u32x4*)(gp + bj * 4096), gb = *(const GAS u32x4*)(gp + bj * 4096 + NEXT);
                    f32x4 r0, r1;
                    r0[0] = bflo(ga.x) * __builtin_amdgcn_rcpf(bflo(gb.x)); r0[1] = bfhi(ga.x) * __builtin_amdgcn_rcpf(bfhi(gb.x));
                    r0[2] = bflo(ga.y) * __builtin_amdgcn_rcpf(bflo(gb.y)); r0[3] = bfhi(ga.y) * __builtin_amdgcn_rcpf(bfhi(gb.y));
                    r1[0] = bflo(ga.z) * __builtin_amdgcn_rcpf(bflo(gb.z)); r1[1] = bfhi(ga.z) * __builtin_amdgcn_rcpf(bfhi(gb.z));
                    r1[2] = bflo(ga.w) * __builtin_amdgcn_rcpf(bflo(gb.w)); r1[3] = bfhi(ga.w) * __builtin_amdgcn_rcpf(bfhi(gb.w));
                    acc[ai][bj][m][0] *= r0; acc[ai][bj][m][1] *= r1;
                }
                gp += 2 * 4096;
            }
        }
    }
    __device__ __forceinline__ void operator()(f32x4 (&acc)[2][2][4][2], const Unit& u, int wr, int wc, int fr, int fq) const {
        const int row0 = u.pm * BM + wr * 64 + fr, colb = u.pn * BM + wc * 32 + 8 * fq;
        if (EK == EK_RES && u.kind > 0) {
            float* pp = part + (size_t)(u.kind - 1) * NCTX * DM - (size_t)NLAT * DM; const float* gm = gmod + 2 * 6144;
#pragma unroll
            for (int bj = 0; bj < 2; ++bj) { const int col = colb + bj * HALF; const f32x4 g0 = *(const f32x4*)(gm + col), g1 = *(const f32x4*)(gm + col + 4);
#pragma unroll
                for (int ai = 0; ai < 2; ++ai)
#pragma unroll
                    for (int m = 0; m < 4; ++m) { const size_t off = (size_t)(row0 + ai * HALF + m * 16) * DM + col;
                        *(f32x4*)(pp + off) = g0 * acc[ai][bj][m][0]; *(f32x4*)(pp + off + 4) = g1 * acc[ai][bj][m][1]; } }
            return;
        }
        if (EK == EK_RES) {
            const bool isctx = u.pm >= 64;
            const float* xi = isctx ? xin_ctx - (size_t)NLAT * DM : xin_lat; float* xo = isctx ? xout_ctx - (size_t)NLAT * DM : xout_lat;
            const float* gm = gmod + (u.pm < 32 ? 0 : (u.pm < 64 ? 1 : 2)) * 6144;
#pragma unroll
            for (int bj = 0; bj < 2; ++bj) { const int col = colb + bj * HALF; const f32x4 g0 = *(const f32x4*)(gm + col), g1 = *(const f32x4*)(gm + col + 4);
#pragma unroll
                for (int ai = 0; ai < 2; ++ai)
#pragma unroll
                    for (int m = 0; m < 4; ++m) { const size_t off = (size_t)(row0 + ai * HALF + m * 16) * DM + col;
                        const f32x4 x0 = *(const f32x4*)(xi + off), x1 = *(const f32x4*)(xi + off + 4);
                        *(f32x4*)(xo + off) = x0 + g0 * acc[ai][bj][m][0]; *(f32x4*)(xo + off + 4) = x1 + g1 * acc[ai][bj][m][1]; } }
            return;
        }
        bf16_t* base; int ld, col0 = colb;
        if (EK == EK_QKV) { if (u.pn < 7) { base = o0; ld = PQ_LD; if (u.pn >= 4) col0 = colb + 512; } else { base = o1; ld = PKV_LD; col0 = colb - 7 * BM; } }
        else if (EK == EK_UKV) { if (u.pn < 2) { base = o0; ld = 512; } else { base = o1; ld = 512; col0 = colb - 512; } }
        else if (EK == EK_GATE) { base = o0; ld = GATE_LD; }
        else if (EK == EK_MERGE) { base = o0; ld = DM; }
        else { base = o0; ld = DFF; }
#pragma unroll
        for (int ai = 0; ai < 2; ++ai)
#pragma unroll
            for (int m = 0; m < 4; ++m) { const int row = row0 + ai * HALF + m * 16; bf16_t* rowp = base + (size_t)row * ld + col0;
#pragma unroll
                for (int bj = 0; bj < 2; ++bj) { f32x4 v0 = acc[ai][bj][m][0], v1 = acc[ai][bj][m][1];
                    if (EK == EK_GATE) {
#pragma unroll
                        for (int e = 0; e < 4; ++e) { v0[e] = fast_sigmoid(v0[e]); v1[e] = fast_sigmoid(v1[e]); } }
                    if (EK == EK_SQRELU) {
#pragma unroll
                        for (int e = 0; e < 4; ++e) { const float a = fmaxf(v0[e], 0.f), b = fmaxf(v1[e], 0.f); v0[e] = a * a; v1[e] = b * b; } }
                    if (EK == EK_MERGE) { const u32x4 g = *(const u32x4*)(gates + gate_tile(2, u.pm, u.pn) + (size_t)((ai * 4 + m) * 2 + bj) * 4096 + ((((wr * 4 + wc) * 64) + fq * 16 + fr) * 8));
                        v0[0] *= bflo(g.x); v0[1] *= bfhi(g.x); v0[2] *= bflo(g.y); v0[3] *= bfhi(g.y); v1[0] *= bflo(g.z); v1[1] *= bfhi(g.z); v1[2] *= bflo(g.w); v1[3] *= bfhi(g.w); }
                    u32x4 w; w.x = pk2(v0[0], v0[1]); w.y = pk2(v0[2], v0[3]); w.z = pk2(v1[0], v1[1]); w.w = pk2(v1[2], v1[3]);
                    if (EK == EK_GATE) *(u32x4*)(o0 + gate_tile(u.pn >> 2, u.pm, u.pn & 3) + (size_t)((ai * 4 + m) * 2 + bj) * 4096 + ((((wr * 4 + wc) * 64) + fq * 16 + fr) * 8)) = w;
                    else *(u32x4*)(rowp + bj * HALF) = w; } }
    }
};
}

__device__ __forceinline__ int crow(int r, int hi) { return (r & 3) + 8 * (r >> 2) + 4 * hi; }
__device__ __forceinline__ float max3f(float a, float b, float c) { return fmaxf(fmaxf(a, b), c); }
__device__ __forceinline__ s16x4 vtr(const LAS unsigned char* p) { return __builtin_bit_cast(s16x4, __builtin_amdgcn_ds_read_tr16_b64_v4i16((LAS s16x4*)p)); }

template <int DK, bool NA>
__device__ __forceinline__ void attn_unit(const int tid, LAS unsigned char* lds,
        const bf16_t* __restrict__ q, bf16_t* o,
        const bf16_t* __restrict__ kbase, const bf16_t* __restrict__ vbase, const bf16_t* __restrict__ krbase,
        const int row_lat, const int row_ctx, int n_lat, float c, const float* __restrict__ rpb, int r0, int rs0, const bool nomax = false) {
    constexpr int KP = DK * 2 + 16, VP = 192, KBUF = 64 * KP, VBUF = 64 * VP, ND = DK / 16;
    constexpr bool VPF = false, KPF = false; constexpr int qld = PQ_LD, old_ = PQ_LD, kld = (DK == 96) ? 512 : PKV_LD, vld = kld;
    const int lane = tid & 63, r32 = lane & 31, hi = lane >> 5, wid = __builtin_amdgcn_readfirstlane(tid >> 6);
    LAS unsigned char* Ks = lds; LAS unsigned char* Vs = lds + 2 * KBUF;
    LAS float* rp = (LAS float*)(lds + 2 * KBUF + 2 * VBUF) + 64;
    const int NT = n_lat + 4;
    const int lkey = tid >> 3, lpart = tid & 7, lkey2 = tid >> 3, lpart2 = tid & 7;
    const unsigned kdst = lkey * KP + lpart * 16, vdst = lkey * VP + lpart * 16, k2dst = lkey2 * KP + 128 + lpart2 * 8;
    u32x4 kregA, vregA, kregB, vregB; u32x2 kreg2A, kreg2B;
#define ATT_LOADK(t, kreg, kreg2) do { const int tk_ = (t); const int rr_ = (tk_ < n_lat) ? row_lat + tk_ * 64 : row_ctx + (tk_ - n_lat) * 64; \
        kreg = *(const u32x4*)(kbase + (size_t)(rr_ + lkey) * kld + lpart * 8); \
        if (DK == 96) kreg2 = *(const u32x2*)(krbase + (size_t)(rr_ + lkey2) * 32 + lpart2 * 4); } while (0)
#define ATT_LOADV(t, vreg) do { const int tv_ = (t); const int rr_ = (tv_ < n_lat) ? row_lat + tv_ * 64 : row_ctx + (tv_ - n_lat) * 64; \
        vreg = *(const u32x4*)(vbase + (size_t)(rr_ + lkey) * vld + lpart * 8); } while (0)
#define ATT_STOREK(buf, kreg, kreg2) do { *(LAS u32x4*)(Ks + (buf) * KBUF + kdst) = kreg; if (DK == 96) *(LAS u32x2*)(Ks + (buf) * KBUF + k2dst) = kreg2; } while (0)
#define ATT_STOREV(buf, vreg) do { *(LAS u32x4*)(Vs + (buf) * VBUF + vdst) = vreg; } while (0)
#define ATT_MFMA __builtin_amdgcn_mfma_f32_32x32x16_bf16
#define ATT_KLOAD(kbuf) do { const LAS unsigned char* Kb_ = Ks + (kbuf) * KBUF + kaddr; \
        _Pragma("unroll") for (int d0 = 0; d0 < ND; ++d0) { kf[d0][0] = *(const LAS bf16x8*)(Kb_ + d0 * 32); kf[d0][1] = *(const LAS bf16x8*)(Kb_ + 32 * KP + d0 * 32); } } while (0)
#define ATT_QK(P0, P1, kbuf, INIT) do { if (!KPF) ATT_KLOAD(kbuf); \
        _Pragma("unroll") for (int d0 = 0; d0 < ND; ++d0) { \
            if (d0 == 0) { P0 = ATT_MFMA(kf[0][0], qf[0], INIT, 0, 0, 0); P1 = ATT_MFMA(kf[0][1], qf[0], INIT, 0, 0, 0); } \
            else { P0 = ATT_MFMA(kf[d0][0], qf[d0], P0, 0, 0, 0); P1 = ATT_MFMA(kf[d0][1], qf[d0], P1, 0, 0, 0); } } } while (0)
    ATT_LOADK(0, kregA, kreg2A); ATT_LOADV(0, vregA);
    bf16x8 qf[ND];
    { const bf16_t* qrow = q + (size_t)(wid * 32 + r32) * qld + hi * 8;
#pragma unroll
      for (int d0 = 0; d0 < ND; ++d0) { const u32x4 w = *(const u32x4*)(qrow + d0 * 16); u32x4 s;
          s.x = pk2(bflo(w.x) * c, bfhi(w.x) * c); s.y = pk2(bflo(w.y) * c, bfhi(w.y) * c); s.z = pk2(bflo(w.z) * c, bfhi(w.z) * c); s.w = pk2(bflo(w.w) * c, bfhi(w.w) * c);
          qf[d0] = __builtin_bit_cast(bf16x8, s); } }
    int qc = 0, cs = 0, rq = 0, rsq = 0;
    if (NA) { qc = 32 * (wid & 1) + r32; cs = min(max(qc - 8, 0), 48); rq = r0 + (wid >> 1); rsq = min(max(rq - 4, 0), 120);
        if (tid < 465) rp[tid] = rpb[tid] * LOG2E; }
    ATT_STOREK(0, kregA, kreg2A); ATT_STOREV(0, vregA);
    ATT_LOADK(1, kregA, kreg2A); ATT_STOREK(1, kregA, kreg2A);
    ATT_LOADK(2, kregA, kreg2A); ATT_LOADV(1, vregA);
    __syncthreads();
    const int g_ = lane >> 4, q_ = (lane & 15) >> 2, p_ = lane & 3;
    const unsigned vaddr = (4 * (g_ >> 1) + q_) * VP + (16 * (g_ & 1) + 4 * p_) * 2;
    const unsigned kaddr = r32 * KP + hi * 16;
    float l_run = 0.f, mxa = 0.f, mxb = 0.f; bool first = true;
    f32x16 o0 = {}, o1 = {}, negm = {};
    f32x16 sa0 = {}, sa1 = {}, sb0 = {}, sb1 = {};
#define ATT_BIASMAX(P0, P1, MX, tt) do { const int tb_ = (tt); \
        if (NA && tb_ < n_lat) { const int bi_ = (rs0 + tb_ - rq + 7) * 31 + 15 - qc; \
            _Pragma("unroll") for (int r = 0; r < 16; ++r) { const int cj = crow(r, hi); \
                P0[r] = ((unsigned)(cj - cs) < 16u) ? P0[r] + rp[bi_ + cj] : -INFINITY; \
                P1[r] = ((unsigned)(cj + 32 - cs) < 16u) ? P1[r] + rp[bi_ + cj + 32] : -INFINITY; } } \
        if (!NA && nomax) { MX = 0.f; break; }                       \
        float mx_ = max3f(P0[0], P0[1], P1[0]), mb_ = max3f(P0[2], P0[3], P1[1]); mx_ = max3f(mx_, P1[2], P1[3]); \
        _Pragma("unroll") for (int r = 4; r < 16; r += 4) { mx_ = max3f(mx_, P0[r], P0[r + 1]); mb_ = max3f(mb_, P0[r + 2], P0[r + 3]); mx_ = max3f(mx_, P1[r], P1[r + 1]); mb_ = max3f(mb_, P1[r + 2], P1[r + 3]); } \
        MX = swap_max(fmaxf(mx_, mb_)); } while (0)
#define ATT_ACTIVE(tt) (!(NA && (tt) < n_lat) || ((rs0 + (tt) >= rsq) && (rs0 + (tt) < rsq + 8)))
    bf16x8 kf[ND][2];
    if (ATT_ACTIVE(0)) { if (KPF) ATT_KLOAD(0); ATT_QK(sa0, sa1, 0, negm); ATT_BIASMAX(sa0, sa1, mxa, 0); }
    __syncthreads();
#define ATT_ITER(t, PA0, PA1, PB0, PB1, MXA, MXB, KI, K2I, VI, KS, K2S, VS) do { const int t_ = (t); const bool hk_ = t_ + 2 < NT, hv_ = t_ + 1 < NT; \
        if (t_ + 3 < NT) ATT_LOADK(t_ + 3, KI, K2I);                  \
        if (t_ + 2 < NT) ATT_LOADV(t_ + 2, VI); \
        const bool act_ = ATT_ACTIVE(t_), actn_ = NA ? (hv_ && ATT_ACTIVE(t_ + 1)) : true; \
        if (act_) { if (first || __any(MXA > 8.f)) {                 \
                const float d_ = first ? MXA : fmaxf(MXA, 0.f), alpha_ = __builtin_amdgcn_exp2f(-d_); \
                PA0 -= d_; PA1 -= d_; negm -= d_; l_run *= alpha_; o0 *= alpha_; o1 *= alpha_; first = false; } } \
        s16x4 vq_[4][4]; \
        if (KPF && actn_) ATT_KLOAD((t_ + 1) & 1); \
        if (VPF && act_) { const LAS unsigned char* Vb_ = Vs + (t_ & 1) * VBUF + vaddr; \
            _Pragma("unroll") for (int s = 0; s < 4; ++s) { const int ro_ = (16 * (s & 1) + 32 * (s >> 1)) * VP; \
                vq_[s][0] = vtr(Vb_ + ro_); vq_[s][1] = vtr(Vb_ + ro_ + 8 * VP); vq_[s][2] = vtr(Vb_ + ro_ + 64); vq_[s][3] = vtr(Vb_ + ro_ + 8 * VP + 64); } } \
        if (KPF) __builtin_amdgcn_sched_barrier(0); \
        __builtin_amdgcn_s_setprio(1); \
        if (actn_) ATT_QK(PB0, PB1, (t_ + 1) & 1, negm); \
        if (act_) { \
            float ps_ = 0.f; \
            _Pragma("unroll") for (int r = 0; r < 16; ++r) { PA0[r] = __builtin_amdgcn_exp2f(PA0[r]); PA1[r] = __builtin_amdgcn_exp2f(PA1[r]); ps_ += PA0[r] + PA1[r]; } \
            l_run += ps_; \
            bf16x8 pa_[4]; \
            _Pragma("unroll") for (int s = 0; s < 2; ++s) { u32x4 w0, w1; \
                w0.x = pk2(PA0[8 * s + 0], PA0[8 * s + 1]); w0.y = pk2(PA0[8 * s + 2], PA0[8 * s + 3]); w0.z = pk2(PA0[8 * s + 4], PA0[8 * s + 5]); w0.w = pk2(PA0[8 * s + 6], PA0[8 * s + 7]); \
                w1.x = pk2(PA1[8 * s + 0], PA1[8 * s + 1]); w1.y = pk2(PA1[8 * s + 2], PA1[8 * s + 3]); w1.z = pk2(PA1[8 * s + 4], PA1[8 * s + 5]); w1.w = pk2(PA1[8 * s + 6], PA1[8 * s + 7]); \
                pa_[s] = __builtin_bit_cast(bf16x8, w0); pa_[2 + s] = __builtin_bit_cast(bf16x8, w1); } \
            const LAS unsigned char* Vc_ = Vs + (t_ & 1) * VBUF + vaddr; \
            _Pragma("unroll") for (int s = 0; s < 4; ++s) { const int ro_ = (16 * (s & 1) + 32 * (s >> 1)) * VP; \
                if (!VPF) { vq_[s][0] = vtr(Vc_ + ro_); vq_[s][1] = vtr(Vc_ + ro_ + 8 * VP); vq_[s][2] = vtr(Vc_ + ro_ + 64); vq_[s][3] = vtr(Vc_ + ro_ + 8 * VP + 64); } \
                const s16x4 a0 = vq_[s][0], a1 = vq_[s][1], b0 = vq_[s][2], b1 = vq_[s][3]; \
                const bf16x8 vf0 = {a0[0], a0[1], a0[2], a0[3], a1[0], a1[1], a1[2], a1[3]}, vf1 = {b0[0], b0[1], b0[2], b0[3], b1[0], b1[1], b1[2], b1[3]}; \
                o0 = ATT_MFMA(vf0, pa_[s], o0, 0, 0, 0); o1 = ATT_MFMA(vf1, pa_[s], o1, 0, 0, 0); } \
        } \
        if (actn_) ATT_BIASMAX(PB0, PB1, MXB, t_ + 1); \
        __builtin_amdgcn_s_setprio(0); \
        if (hk_) ATT_STOREK(t_ & 1, KS, K2S); \
        if (hv_) ATT_STOREV((t_ + 1) & 1, VS); \
        asm volatile("s_waitcnt lgkmcnt(0)\n\ts_barrier" ::: "memory"); } while (0)
    for (int t = 0; t < NT; t += 2) {
        ATT_ITER(t, sa0, sa1, sb0, sb1, mxa, mxb, kregB, kreg2B, vregB, kregA, kreg2A, vregA);
        if (t + 1 < NT) ATT_ITER(t + 1, sb0, sb1, sa0, sa1, mxb, mxa, kregA, kreg2A, vregA, kregB, kreg2B, vregB);
    }
    const float inv = 1.f / swap_sum(l_run);
    bf16_t* orow = o + (size_t)(wid * 32 + r32) * old_ + 4 * hi;
#pragma unroll
    for (int a = 0; a < 4; ++a) {
        u32x2 w0, w1;
        w0.x = pk2(o0[4 * a] * inv, o0[4 * a + 1] * inv); w0.y = pk2(o0[4 * a + 2] * inv, o0[4 * a + 3] * inv);
        w1.x = pk2(o1[4 * a] * inv, o1[4 * a + 1] * inv); w1.y = pk2(o1[4 * a + 2] * inv, o1[4 * a + 3] * inv);
        *(u32x2*)(orow + 8 * a) = w0; *(u32x2*)(orow + 32 + 8 * a) = w1;
    }
#undef ATT_LOADK
#undef ATT_LOADV
#undef ATT_STOREK
#undef ATT_STOREV
#undef ATT_QK
#undef ATT_KLOAD
#undef ATT_ITER
#undef ATT_BIASMAX
#undef ATT_ACTIVE
#undef ATT_MFMA
}


#define XB_TMO      128
#define XB_XCNT(j)  (256  + 64 * (j))
#define XB_XSUB(j)  (1280 + 64 * (j))
#define XB_XGEN(j)  (2304 + 64 * (j))
#define XB_TOP      3328
#define XB_TOPGEN   3392
#define XCD_BAR_WORDS 3456
#define XB_SPIN_CAP (1u << 20)
__device__ __forceinline__ unsigned xb_ld(unsigned* p)              { return __hip_atomic_load(p, __ATOMIC_RELAXED, __HIP_MEMORY_SCOPE_AGENT); }
__device__ __forceinline__ unsigned xb_add(unsigned* p, unsigned v) { return __hip_atomic_fetch_add(p, v, __ATOMIC_RELAXED, __HIP_MEMORY_SCOPE_AGENT); }
__device__ __forceinline__ unsigned xb_xcc_id() { return (unsigned)__builtin_amdgcn_s_getreg((3 << 11) | 20) & 0xFu; }
#define XB_SPIN(cond, bar) do { unsigned _sp = 0; while (cond) { __builtin_amdgcn_s_sleep(1); \
    if ((++_sp & 255u) == 0u) { if (xb_ld(&(bar)[XB_TMO])) break; if (_sp > XB_SPIN_CAP) { atomicAdd(&(bar)[XB_TMO], 1u); break; } } } } while (0)
struct XcdBarrier { unsigned* bar; unsigned x; volatile LAS unsigned* st; };
__device__ __forceinline__ XcdBarrier xcd_barrier_post(unsigned* bar, volatile LAS unsigned* st) {
    XcdBarrier b; b.bar = bar; b.x = xb_xcc_id(); b.st = st;
    if (threadIdx.x == 0) (void)xb_add(&bar[XB_XCNT(b.x)], 1u);
    return b;
}
__device__ __forceinline__ void xcd_barrier_complete(unsigned* bar, unsigned x, unsigned& nloc, unsigned& nx) {
    const unsigned G = gridDim.x * gridDim.y * gridDim.z;
    unsigned sum, cnt, mine, sp = 0u;
    for (;;) {
        sum = 0u; cnt = 0u; mine = 0u;
#pragma unroll
        for (unsigned j = 0; j < 16; ++j) { const unsigned c = xb_ld(&bar[XB_XCNT(j)]); sum += c; cnt += (c > 0u) ? 1u : 0u; mine = (j == x) ? c : mine; }
        if (sum == G) break;
        __builtin_amdgcn_s_sleep(1);
        if ((++sp & 255u) == 0u) { if (xb_ld(&bar[XB_TMO])) break; if (sp > XB_SPIN_CAP) { atomicAdd(&bar[XB_TMO], 1u); break; } }
    }
    nloc = mine > 0u ? mine : 1u; nx = cnt > 0u ? cnt : 1u;
}
__device__ __forceinline__ void xcd_barrier(const XcdBarrier& b) {
    asm volatile("s_waitcnt vmcnt(0)" ::: "memory");
    __syncthreads();
    if (threadIdx.x == 0) {
        unsigned* bar = b.bar;
        __builtin_amdgcn_s_waitcnt(0);
        unsigned nloc = b.st[0], nx = b.st[1];
        if (nloc == 0u) { xcd_barrier_complete(bar, b.x, nloc, nx); b.st[0] = nloc; b.st[1] = nx; }
        const unsigned old = xb_add(&bar[XB_XSUB(b.x)], 1u);
        const unsigned gen = old / nloc;
        if (old + 1u == (gen + 1u) * nloc) {
            __builtin_amdgcn_fence(__ATOMIC_RELEASE, "agent");
            asm volatile("s_waitcnt vmcnt(0)" ::: "memory");
            const unsigned og = xb_add(&bar[XB_TOP], 1u);
            const unsigned tg = og / nx;
            if (og + 1u == (tg + 1u) * nx) xb_add(&bar[XB_TOPGEN], 1u);
            else XB_SPIN(xb_ld(&bar[XB_TOPGEN]) == tg, bar);
            __builtin_amdgcn_fence(__ATOMIC_ACQUIRE, "agent");
            xb_add(&bar[XB_XGEN(b.x)], 1u);
            asm volatile("s_waitcnt vmcnt(0)" ::: "memory");
        } else {
            XB_SPIN(xb_ld(&bar[XB_XGEN(b.x)]) == gen, bar);
            __builtin_amdgcn_fence(__ATOMIC_ACQUIRE, "agent");
            asm volatile("s_waitcnt vmcnt(0)" ::: "memory");
        }
    }
    __syncthreads();
}

struct Args { const float* in[22]; float* out; unsigned char* ws; int ph_lo, ph_hi; };
#define AIN(k) (a.in[(k) + zofs])

__device__ __forceinline__ void wconv(const float* __restrict__ W, int K, int ldw, int c0, int n, bf16_t* __restrict__ Wt, int r0, int ldt, int koff, LAS float* sm, int& rot, int G, int bid, const int tid) {
    const int nkt = K / 128, nnt = n / 32, ntiles = nkt * nnt, ngroups = (ntiles + 3) >> 2;
    int start = bid - rot; if (start < 0) start += G;
    int par = 0;
    for (int g = start; g < ngroups; g += G) {
        LAS float* smb = sm + par * (4 * 128 * 33); par ^= 1;
        f32x4 v[4][2];
#pragma unroll
        for (int j = 0; j < 4; ++j) { const int t = g * 4 + j;
            if (t < ntiles) { const int kt = t / nnt, ntile = t - kt * nnt, k0 = kt * 128, n0 = ntile * 32;
#pragma unroll
                for (int i = 0; i < 2; ++i) v[j][i] = __builtin_nontemporal_load((const f32x4*)(W + (size_t)(k0 + (tid >> 3) + 64 * i) * ldw + c0 + n0 + (tid & 7) * 4)); } }
#pragma unroll
        for (int j = 0; j < 4; ++j) { const int t = g * 4 + j;
            if (t < ntiles) {
#pragma unroll
                for (int i = 0; i < 2; ++i) { LAS float* p = smb + j * (128 * 33) + ((tid >> 3) + 64 * i) * 33 + (tid & 7) * 4; p[0] = v[j][i][0]; p[1] = v[j][i][1]; p[2] = v[j][i][2]; p[3] = v[j][i][3]; } } }
        __syncthreads();
#pragma unroll
        for (int j = 0; j < 4; ++j) { const int t = g * 4 + j;
            if (t < ntiles) { const int kt = t / nnt, ntile = t - kt * nnt, k0 = kt * 128, n0 = ntile * 32;
                const LAS float* p = smb + j * (128 * 33); const int nn = tid >> 4, k8 = (tid & 15) * 8; u32x4 w;
                w.x = pk2(p[(k8 + 0) * 33 + nn], p[(k8 + 1) * 33 + nn]); w.y = pk2(p[(k8 + 2) * 33 + nn], p[(k8 + 3) * 33 + nn]);
                w.z = pk2(p[(k8 + 4) * 33 + nn], p[(k8 + 5) * 33 + nn]); w.w = pk2(p[(k8 + 6) * 33 + nn], p[(k8 + 7) * 33 + nn]);
                *(u32x4*)(Wt + (size_t)(r0 + n0 + nn) * ldt + koff + k0 + k8) = w; } }
    }
    __syncthreads();
    rot = (rot + ngroups) % G;
}

__device__ __forceinline__ void convert_weights(const Args& a, const int zofs, int l, LAS float* sm, int G, int bid, const int tid, const int groups = 7) {
    unsigned char* ws = a.ws; int rot = 0;
    if (groups & 1) {
    bf16_t* WINT = (bf16_t*)(ws + WS_WINT); const float* win = AIN(8) + (size_t)l * DM * WIN_COLS;
    wconv(win, DM, WIN_COLS, 0, 512, WINT, 0, DM, 0, sm, rot, G, bid, tid);
    wconv(win, DM, WIN_COLS, 768, 512, WINT, 512, DM, 0, sm, rot, G, bid, tid);
    wconv(win, DM, WIN_COLS, 2304, 768, WINT, 1024, DM, 0, sm, rot, G, bid, tid);
    wconv(win, DM, WIN_COLS, 512, 256, WINT, 1792, DM, 0, sm, rot, G, bid, tid);
    wconv(win, DM, WIN_COLS, 1280, 1024, WINT, 2048, DM, 0, sm, rot, G, bid, tid);
    wconv(win, DM, WIN_COLS, 3072, 288, WINT, 3072, DM, 0, sm, rot, G, bid, tid);
    wconv(win, DM, WIN_COLS, 3360, 3072, WINT, 3584, DM, 0, sm, rot, G, bid, tid);
    for (int i = bid * 512 + tid; i < 224 * DM / 8; i += G * 512) *(u32x4*)(WINT + (size_t)3360 * DM + (size_t)i * 8) = (u32x4){0u, 0u, 0u, 0u};
    bf16_t* WUKVT = (bf16_t*)(ws + WS_WUKVT);
    wconv(AIN(13) + (size_t)l * 256 * 512, 256, 512, 0, 512, WUKVT, 0, 256, 0, sm, rot, G, bid, tid);
    wconv(AIN(14) + (size_t)l * 256 * 512, 256, 512, 0, 512, WUKVT, 512, 256, 0, sm, rot, G, bid, tid);
    }
    if (groups & 2) {
    bf16_t* WO3T = (bf16_t*)(ws + WS_WO3T);
    wconv(AIN(15) + (size_t)l * 512 * DM, 512, DM, 0, DM, WO3T, 0, 1536, 0, sm, rot, G, bid, tid);
    wconv(AIN(16) + (size_t)l * 512 * DM, 512, DM, 0, DM, WO3T, 0, 1536, 512, sm, rot, G, bid, tid);
    wconv(AIN(17) + (size_t)l * 512 * DM, 512, DM, 0, DM, WO3T, 0, 1536, 1024, sm, rot, G, bid, tid);
    wconv(AIN(18) + (size_t)l * DM * DM, DM, DM, 0, DM, (bf16_t*)(ws + WS_WOUTT), 0, DM, 0, sm, rot, G, bid, tid);
    }
    if (groups & 4) {
    wconv(AIN(19) + (size_t)l * DM * DFF, DM, DFF, 0, DFF, (bf16_t*)(ws + WS_W1T), 0, DM, 0, sm, rot, G, bid, tid);
    wconv(AIN(20) + (size_t)l * DFF * DM, DFF, DM, 0, DM, (bf16_t*)(ws + WS_W2T), 0, DFF, 0, sm, rot, G, bid, tid);
    }
}

__device__ __forceinline__ void norm_mod(const float* xlat, const float* xctx, int nrows, const float* __restrict__ gain, const float* __restrict__ mod, int sh_i, int sc_i, bf16_t* H, int G, int bid, const int tid,
                                         const float* part = nullptr, int nparts = 0, float* xc_out = nullptr) {
    const int lane = tid & 63, wid = tid >> 6;
    for (int row0 = bid * 8 + wid; row0 < nrows; row0 += 2 * G * 8) {
        f32x4 v[2][4]; float ss[2] = {0.f, 0.f}; int rows[2]; bool ok[2];
#pragma unroll
        for (int j = 0; j < 2; ++j) { rows[j] = row0 + j * G * 8; ok[j] = rows[j] < nrows; const int row = ok[j] ? rows[j] : row0;
            const float* xr = row < NLAT ? xlat + (size_t)row * DM : xctx + (size_t)(row - NLAT) * DM;
#pragma unroll
            for (int i = 0; i < 4; ++i) v[j][i] = *(const f32x4*)(xr + lane * 4 + 256 * i); }
#pragma unroll
        for (int j = 0; j < 2; ++j) { const int row = ok[j] ? rows[j] : row0;
            if (nparts > 0 && row >= NLAT) {
                for (int p = 0; p < nparts; ++p) { const float* pr = part + ((size_t)p * NCTX + (row - NLAT)) * DM;
#pragma unroll
                    for (int i = 0; i < 4; ++i) v[j][i] += *(const f32x4*)(pr + lane * 4 + 256 * i); }
                if (xc_out && ok[j]) {
#pragma unroll
                    for (int i = 0; i < 4; ++i) *(f32x4*)(xc_out + (size_t)(row - NLAT) * DM + lane * 4 + 256 * i) = v[j][i]; }
            }
#pragma unroll
            for (int i = 0; i < 4; ++i) ss[j] += v[j][i][0] * v[j][i][0] + v[j][i][1] * v[j][i][1] + v[j][i][2] * v[j][i][2] + v[j][i][3] * v[j][i][3]; }
        ss[0] = wave_sum(ss[0]); ss[1] = wave_sum(ss[1]);
#pragma unroll
        for (int j = 0; j < 2; ++j) { if (!ok[j]) continue; const int row = rows[j];
            const float* mr = mod + (row < SEQ ? 0 : (row < NLAT ? 1 : 2)) * 6144;
            const float rstd = rsqrtf(ss[j] * (1.f / DM) + EPS);
#pragma unroll
            for (int i = 0; i < 4; ++i) { const int col = lane * 4 + 256 * i;
                const f32x4 g = *(const f32x4*)(gain + col), sh = *(const f32x4*)(mr + sh_i * DM + col), sc = *(const f32x4*)(mr + sc_i * DM + col);
                f32x4 h;
#pragma unroll
                for (int e = 0; e < 4; ++e) h[e] = (v[j][i][e] * rstd * g[e]) * (1.f + sc[e]) + sh[e];
                u32x2 w; w.x = pk2(h[0], h[1]); w.y = pk2(h[2], h[3]);
                *(u32x2*)(H + (size_t)row * DM + col) = w; } }
    }
}

__global__ void __launch_bounds__(512, 2) fwd(Args a) {
    extern __shared__ __attribute__((aligned(16))) unsigned char lds_raw[];
    LAS unsigned char* lds = (LAS unsigned char*)lds_raw;
    cg::grid_group grid = cg::this_grid();
    volatile LAS unsigned* xst = (volatile LAS unsigned*)(lds + LDS_BYTES - 16);
    if (threadIdx.x == 0) { xst[0] = 0u; xst[1] = 0u; }
    __syncthreads();
    bool rep2 = false, need_sync = false;
    for (int ph = a.ph_lo; ph < a.ph_hi; ++ph) {
        if (need_sync) { if (ph == a.ph_lo + 1 && !rep2) { grid.sync(); (void)xcd_barrier_post((unsigned*)(a.ws + WS_BAR), (volatile LAS unsigned*)(lds + LDS_BYTES - 16)); }     else { XcdBarrier xb; xb.bar = (unsigned*)(a.ws + WS_BAR); xb.x = xb_xcc_id(); xb.st = (volatile LAS unsigned*)(lds + LDS_BYTES - 16); xcd_barrier(xb); } }
        need_sync = true;
        GAS unsigned char* wsg = (GAS unsigned char*)a.ws; asm volatile("" : "+s"(wsg));
        unsigned char* ws = (unsigned char*)wsg;
        int zofs = 0; asm volatile("" : "+s"(zofs));
        int G = gridDim.x, bid = blockIdx.x, tid = threadIdx.x; asm volatile("" : "+s"(G), "+s"(bid), "+v"(tid));
        const int lane = tid & 63, wid = __builtin_amdgcn_readfirstlane(tid >> 6);
        float* MOD = (float*)(ws + WS_MOD);
        f32x2* TABA = (f32x2*)(ws + WS_TABA); f32x2* TABM = (f32x2*)(ws + WS_TABM);
        float* XC = (float*)(ws + WS_XC);
        bf16_t* H = (bf16_t*)(ws + WS_H); bf16_t* PQ = (bf16_t*)(ws + WS_PQ); bf16_t* PKV = (bf16_t*)(ws + WS_PKV);
        bf16_t* CKV = (bf16_t*)(ws + WS_CKV); bf16_t* MLAKN = (bf16_t*)(ws + WS_MLAKN); bf16_t* MLAV = (bf16_t*)(ws + WS_MLAV); bf16_t* KR = (bf16_t*)(ws + WS_KR);
        bf16_t* GATES = (bf16_t*)(ws + WS_GATES); bf16_t* HID = (bf16_t*)(ws + WS_HID); float* PART = (float*)(ws + WS_CKV);
        const bf16_t* W1T = (const bf16_t*)(ws + WS_W1T); const bf16_t* W2T = (const bf16_t*)(ws + WS_W2T); const bf16_t* WINT = (const bf16_t*)(ws + WS_WINT);
        const bf16_t* WUKVT = (const bf16_t*)(ws + WS_WUKVT); const bf16_t* WO3T = (const bf16_t*)(ws + WS_WO3T); const bf16_t* WOUTT = (const bf16_t*)(ws + WS_WOUTT);

        if (ph == 0) {
            if (bid == 0) for (int i = tid; i < XCD_BAR_WORDS; i += 512) ((unsigned*)(ws + WS_BAR))[i] = 0u;
            convert_weights(a, zofs, 0, (LAS float*)lds, G, bid, tid, G == 256 ? 3 : 7);
            for (int u = bid; u < 192; u += G) {
                const int l = u / 96, j0 = (u % 96) * 64;
                LAS float* sv = (LAS float*)lds; LAS float* red = sv + 3 * 1024;
                for (int i = tid; i < 3 * 1024; i += 512) { const int r = i >> 10, k = i & 1023; const float cv = r < 2 ? AIN(1)[r * DM + k] : AIN(3)[k]; sv[i] = cv / (1.f + __expf(-cv)); }
                __syncthreads();
                const int col = tid & 63, kq = tid >> 6;
                const float* wp = AIN(4) + (size_t)l * DM * 6144 + (size_t)(kq * 128) * 6144 + j0 + col;
                float a0 = 0.f, a1 = 0.f, a2 = 0.f;
#pragma unroll 8
                for (int k = 0; k < 128; ++k) { const float w = wp[(size_t)k * 6144]; a0 += sv[kq * 128 + k] * w; a1 += sv[1024 + kq * 128 + k] * w; a2 += sv[2048 + kq * 128 + k] * w; }
                red[(kq * 3 + 0) * 64 + col] = a0; red[(kq * 3 + 1) * 64 + col] = a1; red[(kq * 3 + 2) * 64 + col] = a2;
                __syncthreads();
                if (tid < 192) { const int r = tid >> 6, cl = tid & 63; float s = 0.f;
#pragma unroll
                    for (int q = 0; q < 8; ++q) s += red[(q * 3 + r) * 64 + cl];
                    MOD[(l * 3 + r) * 6144 + j0 + cl] = s + AIN(5)[l * 6144 + j0 + cl]; }
                __syncthreads();
            }
            for (int i = bid * 512 + tid; i < SEQ * 48; i += G * 512) {
                const int t = i / 48, f = i - t * 48; const float rowf = (float)(t >> 6), colf = (float)(t & 63);
                if (f < 32) { const int fi = f & 15; const float inv = __builtin_amdgcn_exp2f(-(float)(2 * fi) * (13.287712379549449f / 32.f)); const float ang = (f < 16 ? rowf : colf) * inv; TABA[t * 32 + f] = (f32x2){__cosf(ang), __sinf(ang)}; }
                else { const int f2 = f - 32, fi = f2 & 7; const float inv = __builtin_amdgcn_exp2f(-(float)(2 * fi) * (13.287712379549449f / 16.f)); const float ang = (f2 < 8 ? rowf : colf) * inv; TABM[t * 16 + f2] = (f32x2){__cosf(ang), __sinf(ang)}; }
            }
        } else if (ph == NPH - 1) {
            const float* fg = AIN(21);
            for (int row = bid * 8 + wid; row < NLAT; row += G * 8) {
                float* xr = a.out + (size_t)row * DM; f32x4 v[4]; float ss = 0.f;
#pragma unroll
                for (int i = 0; i < 4; ++i) { v[i] = *(const f32x4*)(xr + lane * 4 + 256 * i); ss += v[i][0] * v[i][0] + v[i][1] * v[i][1] + v[i][2] * v[i][2] + v[i][3] * v[i][3]; }
                ss = wave_sum(ss); const float rstd = rsqrtf(ss * (1.f / DM) + EPS);
#pragma unroll
                for (int i = 0; i < 4; ++i) { const f32x4 g = *(const f32x4*)(fg + lane * 4 + 256 * i); *(f32x4*)(xr + lane * 4 + 256 * i) = v[i] * rstd * g; }
            }
        } else {
            const int l = (ph - 1) / 11, sp = (ph - 1) % 11;
            const float* modl = MOD + l * 3 * 6144;
            const int nMfull = 66, nMpost = (l == 0) ? 66 : 64;
            const float* xlat_in = (l == 0) ? AIN(0) : a.out; const float* xctx_in = (l == 0) ? AIN(2) : XC;
            if (sp == 0) {
                if (l == 1) { if (G == 256) {} else if (G >= 64) convert_weights(a, zofs, 1, (LAS float*)lds, G, bid, tid, 4); else convert_weights(a, zofs, 1, (LAS float*)lds, G, bid, tid, 7); }
                norm_mod(xlat_in, xctx_in, MP, AIN(6) + l * DM, modl, 0, 1, H, G, bid, tid, PART, l == 1 ? 16 : 0, nullptr);
            } else if (sp == 1) {
                pg8::TileSched S; S.init(nMfull, 14, G, bid, H, DM, WINT, DM, DM);
                pg8::Epi<pg8::EK_QKV> E{}; E.o0 = PQ; E.o1 = PKV;
                pg8::gemm_phase(tid, lds, DM, DM, S, E);
                { int G2 = gridDim.x, b2 = blockIdx.x, t2 = threadIdx.x, z2 = 0; asm volatile("" : "+s"(G2), "+s"(b2), "+v"(t2), "+s"(z2));
                  if (G2 == 256 && b2 >= 156) convert_weights(a, z2, l, (LAS float*)lds, 100, b2 - 156, t2, 4); }
            } else if (sp == 2) {
                const float* qn = AIN(9) + l * 64; const float* kn = AIN(10) + l * 64; const float* kvn = AIN(12) + l * 256;
                const int l8 = lane & 7;
                for (int row = bid * 8 + wid; row < MP; row += G * 8) {
                    const bool lat = row < NLAT; const int t = row & (SEQ - 1);
                    bf16_t* pq = PQ + (size_t)row * PQ_LD; bf16_t* pkv = PKV + (size_t)row * PKV_LD;
                    f32x2 csa[8];
                    { const f32x4* tp = (const f32x4*)(TABA + (size_t)t * 32 + ((lane >> 2) & 1) * 16 + (lane & 1) * 8);
#pragma unroll
                      for (int e = 0; e < 4; ++e) { const f32x4 c2 = lat ? tp[e] : (f32x4){1.f, 0.f, 1.f, 0.f}; csa[2 * e] = (f32x2){c2[0], c2[1]}; csa[2 * e + 1] = (f32x2){c2[2], c2[3]}; } }
#pragma unroll
                    for (int pass = 0; pass < 2; ++pass) {
                        bf16_t* p = pass == 0 ? pq + lane * 8 : pkv + (lane & 15) * 8;
                        const float* gp = (pass == 0 ? qn : kn) + l8 * 8;
                        const u32x4 w = *(const u32x4*)p; const f32x4 g0 = *(const f32x4*)gp, g1 = *(const f32x4*)(gp + 4);
                        float v[8] = {bflo(w.x), bfhi(w.x), bflo(w.y), bfhi(w.y), bflo(w.z), bfhi(w.z), bflo(w.w), bfhi(w.w)};
                        float ss = 0.f;
#pragma unroll
                        for (int e = 0; e < 8; ++e) ss += v[e] * v[e];
                        ss += __int_as_float(__builtin_amdgcn_update_dpp(0, __float_as_int(ss), 0xB1, 0xf, 0xf, true));
                        ss += __int_as_float(__builtin_amdgcn_update_dpp(0, __float_as_int(ss), 0x4E, 0xf, 0xf, true));
                        ss += __int_as_float(__builtin_amdgcn_update_dpp(0, __float_as_int(ss), 0x141, 0xf, 0xf, true));
                        const float rstd = rsqrtf(ss * (1.f / 64.f) + EPS);
                        float o[8];
#pragma unroll
                        for (int e = 0; e < 8; ++e) { const float y = v[e] * rstd * (e < 4 ? g0[e & 3] : g1[e & 3]);
                            const float pr = __int_as_float(__builtin_amdgcn_update_dpp(0, __float_as_int(y), 0x4E, 0xf, 0xf, true));
                            o[e] = (lane & 2) ? y * csa[e][0] + pr * csa[e][1] : y * csa[e][0] - pr * csa[e][1]; }
                        u32x4 ow; ow.x = pk2(o[0], o[1]); ow.y = pk2(o[2], o[3]); ow.z = pk2(o[4], o[5]); ow.w = pk2(o[6], o[7]);
                        if (pass == 0 || lane < 16) *(u32x4*)p = ow;
                    }
                    f32x2 csm[4];
                    { const f32x4* tp = (const f32x4*)(TABM + (size_t)t * 16 + (l8 >> 2) * 8 + (l8 & 1) * 4);
#pragma unroll
                      for (int e = 0; e < 2; ++e) { const f32x4 c2 = lat ? tp[e] : (f32x4){1.f, 0.f, 1.f, 0.f}; csm[2 * e] = (f32x2){c2[0], c2[1]}; csm[2 * e + 1] = (f32x2){c2[2], c2[3]}; } }
#pragma unroll
                    for (int pass = 0; pass < 2; ++pass) {
                        bf16_t* p = pass == 0 ? pq + 1536 + (lane >> 3) * 96 + 64 + l8 * 4 : pkv + 1536 + l8 * 4;
                        const u32x2 w = *(const u32x2*)p; const float v[4] = {bflo(w.x), bfhi(w.x), bflo(w.y), bfhi(w.y)}; float o[4];
#pragma unroll
                        for (int e = 0; e < 4; ++e) { const float pr = __int_as_float(__builtin_amdgcn_update_dpp(0, __float_as_int(v[e]), 0x4E, 0xf, 0xf, true));
                            o[e] = (lane & 2) ? v[e] * csm[e][0] + pr * csm[e][1] : v[e] * csm[e][0] - pr * csm[e][1]; }
                        u32x2 ow; ow.x = pk2(o[0], o[1]); ow.y = pk2(o[2], o[3]);
                        if (pass == 0) *(u32x2*)p = ow; else if (lane < 8) *(u32x2*)(KR + (size_t)row * 32 + l8 * 4) = ow;
                    }
                    { const u32x2 w = *(const u32x2*)(pkv + 1280 + lane * 4); const float v0 = bflo(w.x), v1 = bfhi(w.x), v2 = bflo(w.y), v3 = bfhi(w.y);
                      const float ss = wave_sum(v0 * v0 + v1 * v1 + v2 * v2 + v3 * v3); const float rstd = rsqrtf(ss * (1.f / 256.f) + EPS);
                      const f32x4 g = *(const f32x4*)(kvn + lane * 4); u32x2 o; o.x = pk2(v0 * rstd * g[0], v1 * rstd * g[1]); o.y = pk2(v2 * rstd * g[2], v3 * rstd * g[3]);
                      *(u32x2*)(CKV + (size_t)row * 256 + lane * 4) = o; }
                }
            } else if (sp == 3) {
                pg8::TileSched S; S.init(nMfull, 4, G, bid, CKV, 256, WUKVT, 256, 256);
                pg8::Epi<pg8::EK_UKV> E{}; E.o0 = MLAKN; E.o1 = MLAV;
                pg8::gemm_phase(tid, lds, 256, 256, S, E);
            } else if (sp == 4) {
                const int total = 1536 + (l == 0 ? 48 : 0);
                const float c64 = 0.125f * LOG2E, c96 = 0.10206207261596577f * LOG2E;
                bool gqa_nomax; { float gqm = 0.f, gkm = 0.f; const float* qn_ = AIN(9) + l * 64; const float* kn_ = AIN(10) + l * 64;
                    for (int i = 0; i < 64; ++i) { gqm = fmaxf(gqm, fabsf(qn_[i])); gkm = fmaxf(gkm, fabsf(kn_[i])); }
                    gqa_nomax = (11.8f * gqm * gkm < 40.f); }
                for (int u = (DUPMASK && rep2) ? 512 + bid : bid; u < ((DUPMASK && rep2) ? 1024 : total); u += G) {
                    int tidu = tid; asm volatile("" : "+v"(tidu));
                    if (u < 512) {
                        const int xcd = u & 7, within = u >> 3, combo = xcd >> 1, b = combo >> 1, kvh = combo & 1, sub = (xcd & 1) * 64 + within, h = kvh * 4 + (sub >> 5), qb = sub & 31;
                        bf16_t* qp = PQ + ((size_t)b * SEQ + qb * 256) * PQ_LD + h * 64;
                        attn_unit<64, false>(tidu, lds, qp, qp, PKV + kvh * 64, PKV + 128 + kvh * 64, nullptr, b * SEQ, NLAT + b * CTXL, 128, c64, nullptr, 0, 0, gqa_nomax);
                    } else if (u < 1024) {
                        const int idx = u - 512, xcd = idx & 7, within = idx >> 3, combo = xcd * 2 + (within >> 5), b = combo >> 3, h = combo & 7, qb = within & 31;
                        bf16_t* qp = PQ + ((size_t)b * SEQ + qb * 256) * PQ_LD;
                        attn_unit<96, false>(tidu, lds, qp + 1536 + h * 96, qp + 1024 + h * 64, MLAKN + h * 64, MLAV + h * 64, KR, b * SEQ, NLAT + b * CTXL, 128, c96, nullptr, 0, 0);
                    } else if (u < 1536) {
                        const int idx = u - 1024, h = idx & 7, within = idx >> 3, b = within >> 5, rg = within & 31;
                        const int r0 = rg * 4, rs0 = min(max(r0 - 4, 0), 120), rse = min(max(r0 - 1, 0), 120) + 8;
                        bf16_t* qp = PQ + ((size_t)b * SEQ + rg * 256) * PQ_LD + 512 + h * 64;
                        attn_unit<64, true>(tidu, lds, qp, qp, PKV + 256 + h * 64, PKV + 768 + h * 64, nullptr, b * SEQ + rs0 * 64, NLAT + b * CTXL, rse - rs0, c64,
                                            AIN(11) + (size_t)(l * 8 + h) * 465, r0, rs0);
                    } else {
                        const int j = u - 1536, ty = j >> 4, b = (j >> 3) & 1, h = j & 7;
                        const int rowc = NLAT + b * CTXL;
                        bf16_t* qp = PQ + (size_t)rowc * PQ_LD;
                        if (ty == 0) { const int kvh = h >> 2;
                            attn_unit<64, false>(tidu, lds, qp + h * 64, qp + h * 64, PKV + kvh * 64, PKV + 128 + kvh * 64, nullptr, 0, rowc, 0, c64, nullptr, 0, 0);
                        } else if (ty == 1) {
                            attn_unit<64, false>(tidu, lds, qp + 512 + h * 64, qp + 512 + h * 64, PKV + 256 + h * 64, PKV + 768 + h * 64, nullptr, 0, rowc, 0, c64, nullptr, 0, 0);
                        } else {
                            attn_unit<96, false>(tidu, lds, qp + 1536 + h * 96, qp + 1024 + h * 64, MLAKN + h * 64, MLAV + h * 64, KR, 0, rowc, 0, c96, nullptr, 0, 0);
                        }
                    }
                }
            } else if (sp == 5) {
                pg8::TileSched S; S.init(nMpost, 12, G, bid, H, DM, WINT + (size_t)3584 * DM, DM, DM);
                pg8::Epi<pg8::EK_GATE> E{}; E.o0 = GATES;
                pg8::gemm_phase(tid, lds, DM, DM, S, E);
            } else if (sp == 6) {
                pg8::TileSched S; S.init(nMpost, 4, G, bid, PQ, PQ_LD, WO3T, 1536, 1536);
                pg8::Epi<pg8::EK_MERGE> E{}; E.o0 = H; E.gates = GATES;
                pg8::gemm_phase(tid, lds, PQ_LD, 1536, S, E);
                if (l == 0) { int G2 = gridDim.x, b2 = blockIdx.x, t2 = threadIdx.x, z2 = 0; asm volatile("" : "+s"(G2), "+s"(b2), "+v"(t2), "+s"(z2));
                    if (G2 >= 64 && b2 >= 8) convert_weights(a, z2, 1, (LAS float*)lds, G2 - 8, b2 - 8, t2, 1); }
            } else if (sp == 7) {
                pg8::TileSched S; S.init(64, 4, G, bid, H, DM, WOUTT, DM, DM); if (l == 0) S.split_ctx(8);
                pg8::Epi<pg8::EK_RES> E{}; E.xin_lat = xlat_in; E.xin_ctx = xctx_in; E.xout_lat = a.out; E.xout_ctx = XC; E.gmod = modl + 2 * DM; E.part = PART;
                pg8::gemm_phase(tid, lds, DM, DM, S, E);
            } else if (sp == 8) {
                norm_mod(a.out, l == 0 ? AIN(2) : XC, nMpost * 256, AIN(7) + l * DM, modl, 3, 4, H, G, bid, tid, PART, l == 0 ? 8 : 0, XC);
            } else if (sp == 9) {
                pg8::TileSched S; S.init(nMpost, 16, G, bid, H, DM, W1T, DM, DM);
                pg8::Epi<pg8::EK_SQRELU> E{}; E.o0 = HID;
                pg8::gemm_phase(tid, lds, DM, DM, S, E);
                if (l == 0) { int G2 = gridDim.x, b2 = blockIdx.x, t2 = threadIdx.x, z2 = 0; asm volatile("" : "+s"(G2), "+s"(b2), "+v"(t2), "+s"(z2));
                    if (G2 >= 64 && b2 >= 32) convert_weights(a, z2, 1, (LAS float*)lds, G2 - 32, b2 - 32, t2, 2); }
            } else {
                pg8::TileSched S; S.init(64, 4, G, bid, HID, DFF, W2T, DFF, DFF); if (l == 0) S.split_ctx(16);
                pg8::Epi<pg8::EK_RES> E{}; E.xin_lat = a.out; E.xin_ctx = XC; E.xout_lat = a.out; E.xout_ctx = XC; E.gmod = modl + 5 * DM; E.part = PART;
                pg8::gemm_phase(tid, lds, DFF, DFF, S, E);
            }
        }
        if (DUPMASK) {
            bool dup = false;
            if (ph == 0) dup = (DUPMASK & 1);
            else if (ph < NPH - 1) { const int l_ = (ph - 1) / 11, sp_ = (ph - 1) % 11; dup = ((DUPMASK >> (1 + sp_)) & 1) && sp_ != 2 && sp_ != 10 && !(sp_ == 7 && l_ == 1); }
            if (dup && !rep2) { rep2 = true; --ph; } else rep2 = false;
        }
    }
}

extern "C" void kernel_launch(void* const* d_in, const int* in_sizes, int n_in, void* d_out, int out_size, void* d_ws, size_t ws_size, hipStream_t stream) {
    static int grid = 0;
    if (grid == 0) {
        if (n_in != 22 || ws_size < WS_END) { fprintf(stderr, "kernel_launch: unexpected n_in %d / ws %zu\n", n_in, ws_size); grid = -1; return; }
        int dev = 0, cus = 0, per_cu = 0;
        hipGetDevice(&dev); hipDeviceGetAttribute(&cus, hipDeviceAttributeMultiprocessorCount, dev);
        if (hipFuncSetAttribute((const void*)fwd, hipFuncAttributeMaxDynamicSharedMemorySize, LDS_BYTES) != hipSuccess) { fprintf(stderr, "kernel_launch: hipFuncSetAttribute failed\n"); grid = -1; return; }
        if (hipOccupancyMaxActiveBlocksPerMultiprocessor(&per_cu, (const void*)fwd, 512, LDS_BYTES) != hipSuccess || per_cu < 1) { fprintf(stderr, "kernel_launch: occupancy query gave %d\n", per_cu); per_cu = 1; }
        (void)hipGetLastError();
        grid = cus * 1;
    }
    if (grid < 0) return;
    Args a{};
    for (int i = 0; i < 22; ++i) a.in[i] = (const float*)d_in[i];
    a.out = (float*)d_out; a.ws = (unsigned char*)d_ws;
#if N_LAUNCH_MODE == 1
    a.ph_lo = 0; a.ph_hi = NPH;
    void* args[] = {&a};
    hipError_t e = hipLaunchCooperativeKernel((const void*)fwd, dim3(grid), dim3(512), args, LDS_BYTES, stream);
    if (e != hipSuccess) fprintf(stderr, "cooperative launch failed: %s (grid %d)\n", hipGetErrorString(e), grid);
#else
    for (int ph = 0; ph < NPH; ++ph) { a.ph_lo = ph; a.ph_hi = ph + 1; hipLaunchKernelGGL(fwd, dim3(grid), dim3(512), LDS_BYTES, stream, a); }
#endif
}
```

```cpp
#include <hip/hip_runtime.h>
#include <hip/hip_cooperative_groups.h>
#include <cstdio>
#include <cstdint>
namespace cg = cooperative_groups;

#ifndef DUPMASK
#define DUPMASK 0
#endif
#ifndef N_LAUNCH_MODE
#define N_LAUNCH_MODE 1
#endif

#define LAS __attribute__((address_space(3)))
#define GAS __attribute__((address_space(1)))
typedef unsigned short bf16_t;
typedef short bf16x8 __attribute__((ext_vector_type(8)));
typedef short s16x4 __attribute__((ext_vector_type(4)));
typedef float f32x2 __attribute__((ext_vector_type(2)));
typedef float f32x4 __attribute__((ext_vector_type(4)));
typedef float f32x16 __attribute__((ext_vector_type(16)));
typedef unsigned u32x2 __attribute__((ext_vector_type(2)));
typedef unsigned u32x4 __attribute__((ext_vector_type(4)));
typedef __bf16 bf16x2_t __attribute__((ext_vector_type(2)));

constexpr int DM = 1024, SEQ = 8192, NLAT = 16384, CTXL = 256, NCTX = 512, MP = 16896, DFF = 4096;
constexpr int WIN_COLS = 6432;
constexpr int PQ_LD = 2304, PKV_LD = 1792, GATE_LD = 3072;
constexpr float EPS = 1e-6f;
constexpr float LOG2E = 1.4426950408889634f;
constexpr int NPH = 24;

constexpr size_t KiB = 1024, MiB = 1u << 20;
constexpr size_t WS_MOD = 0;
constexpr size_t WS_BAR = 512 * KiB;
constexpr size_t WS_TABA = 1 * MiB;
constexpr size_t WS_TABM = 3 * MiB;
constexpr size_t WS_XC = 4 * MiB;
constexpr size_t WS_W1T = 6 * MiB, WS_W2T = 14 * MiB, WS_WINT = 22 * MiB, WS_WUKVT = 35 * MiB, WS_WO3T = 35 * MiB + 512 * KiB, WS_WOUTT = 38 * MiB + 512 * KiB;
constexpr size_t WS_H = 40 * MiB + 512 * KiB;
constexpr size_t WS_PQ = WS_H + (size_t)MP * 1024 * 2;
constexpr size_t WS_PKV = WS_PQ + (size_t)MP * PQ_LD * 2;
constexpr size_t WS_CKV = WS_PKV + (size_t)MP * PKV_LD * 2;
constexpr size_t WS_MLAKN = WS_CKV + (size_t)MP * 256 * 2;
constexpr size_t WS_MLAV = WS_MLAKN + (size_t)MP * 512 * 2;
constexpr size_t WS_KR = WS_MLAV + (size_t)MP * 512 * 2;
constexpr size_t WS_END = WS_KR + (size_t)MP * 32 * 2;
constexpr size_t WS_GATES = WS_PKV;
constexpr size_t WS_HID = WS_PQ;
static_assert(WS_GATES + (size_t)MP * GATE_LD * 2 <= WS_KR, "gates overlay");
static_assert(WS_HID + (size_t)MP * DFF * 2 <= WS_END, "hid overlay");
constexpr size_t WS_MPART = 249 * MiB;
static_assert(WS_END <= WS_MPART && WS_MPART + 6 * MiB <= 256 * MiB, "workspace");

constexpr int LDS_BYTES = 147456;

__device__ __forceinline__ float bf2f(bf16_t v) { return __uint_as_float(((unsigned)v) << 16); }
__device__ __forceinline__ float bflo(unsigned w) { return __uint_as_float(w << 16); }
__device__ __forceinline__ float bfhi(unsigned w) { return __uint_as_float(w & 0xffff0000u); }
__device__ __forceinline__ unsigned pk2(float lo, float hi) { f32x2 v = {lo, hi}; bf16x2_t b = __builtin_convertvector(v, bf16x2_t); return __builtin_bit_cast(unsigned, b); }
__device__ __forceinline__ bf16_t f2bf(float f) { return (bf16_t)(pk2(f, 0.f) & 0xffffu); }
__device__ __forceinline__ float wave_sum(float v) {
    v += __int_as_float(__builtin_amdgcn_update_dpp(0, __float_as_int(v), 0xB1, 0xf, 0xf, true));
    v += __int_as_float(__builtin_amdgcn_update_dpp(0, __float_as_int(v), 0x4E, 0xf, 0xf, true));
    v += __int_as_float(__builtin_amdgcn_update_dpp(0, __float_as_int(v), 0x141, 0xf, 0xf, true));
    v += __int_as_float(__builtin_amdgcn_update_dpp(0, __float_as_int(v), 0x140, 0xf, 0xf, true));
    const float s0 = __int_as_float(__builtin_amdgcn_readlane(__float_as_int(v), 0)), s1 = __int_as_float(__builtin_amdgcn_readlane(__float_as_int(v), 16));
    const float s2 = __int_as_float(__builtin_amdgcn_readlane(__float_as_int(v), 32)), s3 = __int_as_float(__builtin_amdgcn_readlane(__float_as_int(v), 48));
    return (s0 + s1) + (s2 + s3);
}
__device__ __forceinline__ float swap_max(float m) { auto rr = __builtin_amdgcn_permlane32_swap(__float_as_uint(m), __float_as_uint(m), false, false); return fmaxf(__uint_as_float(rr[0]), __uint_as_float(rr[1])); }
__device__ __forceinline__ float swap_sum(float m) { auto rr = __builtin_amdgcn_permlane32_swap(__float_as_uint(m), __float_as_uint(m), false, false); return __uint_as_float(rr[0]) + __uint_as_float(rr[1]); }
__device__ __forceinline__ float fast_sigmoid(float x) { return fmaxf(__builtin_amdgcn_rcpf(1.f + __builtin_amdgcn_exp2f(-x * LOG2E)), 1e-30f); }

namespace pg8 {
constexpr int BM = 256, BK = 64, HALF = 128, HTB = HALF * BK * 2, STAGE_BYTES = 8 * HTB, NXCD = 8, WGM = 8;
__device__ __forceinline__ int lds_byte(int r, int c) { const int st = (r >> 4) * 2 + (c >> 5), rr = r & 15, cc = c & 31, ob = rr * 64 + cc * 2; return st * 1024 + (ob ^ (((ob >> 9) & 1) << 5)); }
__device__ __forceinline__ void stage_rc(int b, int& R, int& C) { const int st = b / 1024, sb = b % 1024, swz = sb ^ (((sb >> 9) & 1) << 5); R = (st >> 1) * 16 + swz / 64; C = (st & 1) * 32 + (swz % 64) / 2; }
__device__ __forceinline__ int perm32(int rho) { const int n = rho >> 4, i = rho & 15; return 8 * (i >> 2) + 4 * n + (i & 3); }

struct Unit { const char* a; const char* b; int nt; int kind; int pm; int pn; };

template <class Epi, class Sched>
__device__ __forceinline__ void gemm_phase(const int tid, LAS unsigned char* lds, const int lda, const int ldb, const Sched& S, const Epi& E) {
    const int wid = __builtin_amdgcn_readfirstlane(tid >> 6), lane = tid & 63, wr = wid >> 2, wc = wid & 3, fr = lane & 15, fq = lane >> 4;
    unsigned voffA[2], voffB[2];
#pragma unroll
    for (int i = 0; i < 2; ++i) { int R, C; stage_rc(tid * 16 + i * 8192, R, C); const int Rb = (R & ~31) + perm32(R & 31);
        voffA[i] = (unsigned)(R * lda + C) * 2u; voffB[i] = (unsigned)(Rb * ldb + C) * 2u; }
    const size_t kstep = (size_t)(BK * 2);
    const size_t hstepA = (size_t)HALF * lda * 2, hstepB = (size_t)HALF * ldb * 2;
    const unsigned ldsw = (unsigned)wid * 1024u;
    const int aoff = lds_byte(wr * 64 + fr, fq * 8), boff = lds_byte(wc * 32 + fr, fq * 8);
#define PG8_SA(b, h) (((b) * 2 + (h)) * HTB)
#define PG8_SB(b, h) ((4 + (b) * 2 + (h)) * HTB)
#define PG8_STAGE(bufoff, gbase, voff) do { _Pragma("unroll") for (int _i = 0; _i < 2; ++_i) \
        __builtin_amdgcn_global_load_lds((const unsigned*)((const char*)(gbase) + (voff)[_i]), (LAS unsigned*)(lds + (bufoff) + ldsw + _i * 8192), 16, 0, 0); } while (0)
#define PG8_LDA(dst, b, h) do { _Pragma("unroll") for (int m = 0; m < 4; ++m) _Pragma("unroll") for (int k = 0; k < 2; ++k) dst[m][k] = *(const LAS bf16x8*)(lds + PG8_SA(b, h) + aoff + m * 2048 + k * 1024); } while (0)
#define PG8_LDB(dst, b, h) do { _Pragma("unroll") for (int n = 0; n < 2; ++n) _Pragma("unroll") for (int k = 0; k < 2; ++k) dst[n][k] = *(const LAS bf16x8*)(lds + PG8_SB(b, h) + boff + n * 2048 + k * 1024); } while (0)
#define PG8_MMA(ai, bj, At, Bt) do { __builtin_amdgcn_s_setprio(1); _Pragma("unroll") for (int m = 0; m < 4; ++m) _Pragma("unroll") for (int n = 0; n < 2; ++n) _Pragma("unroll") for (int k = 0; k < 2; ++k) \
        acc[ai][bj][m][n] = __builtin_amdgcn_mfma_f32_16x16x32_bf16(Bt[n][k], At[m][k], acc[ai][bj][m][n], 0, 0, 0); __builtin_amdgcn_s_setprio(0); } while (0)
#define PG8_WAIT_V(n) asm volatile("s_waitcnt vmcnt(" #n ")" ::: "memory")
#define PG8_WAIT_L(n) asm volatile("s_waitcnt lgkmcnt(" #n ")" ::: "memory")
#define PG8_BAR __builtin_amdgcn_s_barrier()
#define PG8_SCHED __builtin_amdgcn_sched_barrier(0)
    Unit cur, nxt; int ui = 0;
    if (!S.next(0, cur)) return;
    f32x4 acc[2][2][4][2];
#pragma unroll
    for (int a = 0; a < 2; ++a)
#pragma unroll
        for (int b = 0; b < 2; ++b)
#pragma unroll
            for (int m = 0; m < 4; ++m)
#pragma unroll
                for (int n = 0; n < 2; ++n) acc[a][b][m][n] = (f32x4){0.f, 0.f, 0.f, 0.f};
    bf16x8 At[4][2], B0[2][2], B1[2][2];
    const char* cA = cur.a; const char* cB = cur.b;
    PG8_STAGE(PG8_SB(0, 0), cB, voffB); PG8_STAGE(PG8_SB(0, 1), cB + hstepB, voffB); PG8_STAGE(PG8_SA(0, 0), cA, voffA); PG8_STAGE(PG8_SA(0, 1), cA + hstepA, voffA);
    if (wr == 1) PG8_BAR;
    PG8_WAIT_V(2); PG8_BAR;
    PG8_STAGE(PG8_SB(1, 0), cB + kstep, voffB); PG8_STAGE(PG8_SA(1, 0), cA + kstep, voffA); PG8_STAGE(PG8_SB(1, 1), cB + hstepB + kstep, voffB);
    PG8_WAIT_V(6); PG8_BAR;
    for (;;) {
        const bool has_next = S.next(ui + 1, nxt);
        const char* nA = has_next ? nxt.a : cA; const char* nB = has_next ? nxt.b : cB;
        const int nt = cur.nt;
        for (int t = 0; t < nt; t += 2) {
            if constexpr (Epi::HOOK) { if (t == 8 || t == 16) { if (wr == 0) PG8_BAR; E.hook(acc, cur, (t >> 3) - 1, wr, wc, fr, fq); if (wr == 1) PG8_BAR; } }
            const bool last = (t == nt - 2);
            const char* a1 = cA + (size_t)(t + 1) * kstep;
            const char* a2 = last ? nA : cA + (size_t)(t + 2) * kstep; const char* b2 = last ? nB : cB + (size_t)(t + 2) * kstep;
            const char* a3 = a2 + kstep; const char* b3 = b2 + kstep;
            PG8_LDB(B0, 0, 0); PG8_LDB(B1, 0, 1); PG8_SCHED; PG8_LDA(At, 0, 0); PG8_STAGE(PG8_SA(1, 1), a1 + hstepA, voffA);
            PG8_WAIT_V(8); PG8_WAIT_L(0); PG8_BAR; PG8_MMA(0, 0, At, B0); PG8_MMA(0, 1, At, B1); PG8_BAR; PG8_SCHED;
            PG8_LDA(At, 0, 1); PG8_STAGE(PG8_SB(0, 0), b2, voffB); PG8_STAGE(PG8_SB(0, 1), b2 + hstepB, voffB); PG8_STAGE(PG8_SA(0, 0), a2, voffA);
            PG8_WAIT_V(8); PG8_WAIT_L(0); PG8_BAR; PG8_MMA(1, 0, At, B0); PG8_MMA(1, 1, At, B1); PG8_BAR; PG8_SCHED;
            PG8_LDB(B0, 1, 0); PG8_LDB(B1, 1, 1); PG8_SCHED; PG8_LDA(At, 1, 0); PG8_STAGE(PG8_SA(0, 1), a2 + hstepA, voffA);
            PG8_WAIT_V(8); PG8_WAIT_L(0); PG8_BAR; PG8_MMA(0, 0, At, B0); PG8_MMA(0, 1, At, B1); PG8_BAR; PG8_SCHED;
            PG8_LDA(At, 1, 1); PG8_STAGE(PG8_SB(1, 0), b3, voffB); PG8_STAGE(PG8_SB(1, 1), b3 + hstepB, voffB); PG8_STAGE(PG8_SA(1, 0), a3, voffA);
            PG8_WAIT_V(8); PG8_WAIT_L(0); PG8_BAR; PG8_MMA(1, 0, At, B0); PG8_MMA(1, 1, At, B1); PG8_BAR; PG8_SCHED;
        }
        if (wr == 0) PG8_BAR;
        E(acc, cur, wr, wc, fr, fq);
        if (!has_next) break;
#pragma unroll
        for (int a = 0; a < 2; ++a)
#pragma unroll
            for (int b = 0; b < 2; ++b)
#pragma unroll
                for (int m = 0; m < 4; ++m)
#pragma unroll
                    for (int n = 0; n < 2; ++n) acc[a][b][m][n] = (f32x4){0.f, 0.f, 0.f, 0.f};
        cur = nxt; cA = nA; cB = nB; ++ui;
        if (wr == 1) PG8_BAR;
    }
    PG8_WAIT_V(0);
    PG8_BAR;
#undef PG8_SA
#undef PG8_SB
#undef PG8_STAGE
#undef PG8_LDA
#undef PG8_LDB
#undef PG8_MMA
#undef PG8_WAIT_V
#undef PG8_WAIT_L
#undef PG8_BAR
#undef PG8_SCHED
}

struct TileSched {
    int nM, nN, nwg, G, c; const char* A; const char* Bt; size_t atile, btile; int nt;
    int nchunk = 0, nlat_mine = 0;
    __device__ __forceinline__ void init(int nM_, int nN_, int G_, int c_, const void* A_, int lda, const void* Bt_, int ldb, int K) {
        nM = nM_; nN = nN_; nwg = nM * nN; G = G_; c = c_; A = (const char*)A_; Bt = (const char*)Bt_; atile = (size_t)BM * lda * 2; btile = (size_t)BM * ldb * 2; nt = K / BK; }
    __device__ __forceinline__ void split_ctx(int nchunk_) { nchunk = nchunk_; nlat_mine = c < nwg ? (nwg - c + G - 1) / G : 0; }
    __device__ __forceinline__ bool next(int i, Unit& u) const {
        if (nchunk > 0 && i >= nlat_mine) {
            const long s = (long)(i - nlat_mine) * G + c; if (s >= 2 * nN * nchunk) return false;
            const int chunk = (int)s % nchunk, up = (int)s / nchunk, ntc = nt / nchunk;
            u.pm = 64 + up / nN; u.pn = up % nN; u.nt = ntc; u.kind = 1 + chunk;
            u.a = A + (size_t)u.pm * atile + (size_t)chunk * ntc * (BK * 2); u.b = Bt + (size_t)u.pn * btile + (size_t)chunk * ntc * (BK * 2); return true;
        }
        const long L = (long)i * G + c; if (L >= nwg) return false;
        int wgid = (int)L; { const int q = nwg / NXCD, r = nwg % NXCD, xcd = wgid % NXCD, off = wgid / NXCD; wgid = (xcd < r ? xcd * (q + 1) : r * (q + 1) + (xcd - r) * q) + off; }
        const int nig = WGM * nN, gid = wgid / nig, fm = gid * WGM, gsz = (nM - fm) < WGM ? (nM - fm) : WGM;
        u.pm = fm + ((wgid % nig) % gsz); u.pn = (wgid % nig) / gsz;
        u.a = A + (size_t)u.pm * atile; u.b = Bt + (size_t)u.pn * btile; u.nt = nt; u.kind = 0; return true;
    }
};
__device__ __forceinline__ size_t gate_tile(int br, int pm, int pn) { return ((size_t)((br * 66 + pm) * 4 + pn)) * 65536; }
enum { EK_QKV = 0, EK_UKV, EK_GATE, EK_MERGE, EK_RES, EK_SQRELU };
template <int EK> struct Epi {
    bf16_t* o0; bf16_t* o1;
    const bf16_t* gates;
    const float* xin_lat; const float* xin_ctx; float* xout_lat; float* xout_ctx; const float* gmod; float* part;
    static constexpr bool HOOK = (EK == EK_MERGE);
    __device__ __forceinline__ void hook(f32x4 (&acc)[2][2][4][2], const Unit& u, const int seg, int wr, int wc, int fr, int fq) const {
        const int tid8 = (((wr * 4 + wc) * 64) + fq * 16 + fr) * 8;
        const GAS bf16_t* gp = (const GAS bf16_t*)gates + gate_tile(seg, u.pm, u.pn) + tid8;
        constexpr size_t NEXT = (size_t)66 * 4 * 65536;
#pragma unroll
        for (int ai = 0; ai < 2; ++ai) {
            asm volatile("" : "+v"(gp));
#pragma unroll
            for (int m = 0; m < 4; ++m) {
#pragma unroll
                for (int bj = 0; bj < 2; ++bj) {
                    const u32x4 ga = *(const GAS u32x4*)(gp + bj * 4096), gb = *(const GAS u32x4*)(gp + bj * 4096 + NEXT);
                    f32x4 r0, r1;
                    r0[0] = bflo(ga.x) * __builtin_amdgcn_rcpf(bflo(gb.x)); r0[1] = bfhi(ga.x) * __builtin_amdgcn_rcpf(bfhi(gb.x));
                    r0[2] = bflo(ga.y) * __builtin_amdgcn_rcpf(bflo(gb.y)); r0[3] = bfhi(ga.y) * __builtin_amdgcn_rcpf(bfhi(gb.y));
                    r1[0] = bflo(ga.z) * __builtin_amdgcn_rcpf(bflo(gb.z)); r1[1] = bfhi(ga.z) * __builtin_amdgcn_rcpf(bfhi(gb.z));
                    r1[2] = bflo(ga.w) * __builtin_amdgcn_rcpf(bflo(gb.w)); r1[3] = bfhi(ga.w) * __builtin_amdgcn_rcpf(bfhi(gb.w));
                    acc[ai][bj][m][0] *= r0; acc[ai][bj][m][1] *= r1;
                }
                gp += 2 * 4096;
            }
        }
    }
    __device__ __forceinline__ void operator()(f32x4 (&acc)[2][2][4][2], const Unit& u, int wr, int wc, int fr, int fq) const {
        const int row0 = u.pm * BM + wr * 64 + fr, colb = u.pn * BM + wc * 32 + 8 * fq;
        if (EK == EK_MERGE && u.kind > 0) {
            float* pp = part + (size_t)(u.kind - 1) * NCTX * DM - (size_t)NLAT * DM;
            const bf16_t* gb = gates + gate_tile(u.kind - 1, u.pm, u.pn) + ((((wr * 4 + wc) * 64) + fq * 16 + fr) * 8);
#pragma unroll
            for (int ai = 0; ai < 2; ++ai)
#pragma unroll
                for (int m = 0; m < 4; ++m)
#pragma unroll
                    for (int bj = 0; bj < 2; ++bj) { const u32x4 g = *(const u32x4*)(gb + (size_t)((ai * 4 + m) * 2 + bj) * 4096); const size_t off = (size_t)(row0 + ai * HALF + m * 16) * DM + colb + bj * HALF;
                        f32x4 v0 = acc[ai][bj][m][0], v1 = acc[ai][bj][m][1];
                        v0[0] *= bflo(g.x); v0[1] *= bfhi(g.x); v0[2] *= bflo(g.y); v0[3] *= bfhi(g.y); v1[0] *= bflo(g.z); v1[1] *= bfhi(g.z); v1[2] *= bflo(g.w); v1[3] *= bfhi(g.w);
                        *(f32x4*)(pp + off) = v0; *(f32x4*)(pp + off + 4) = v1; }
            return;
        }
        if (EK == EK_RES && u.kind > 0) {
            float* pp = part + (size_t)(u.kind - 1) * NCTX * DM - (size_t)NLAT * DM; const float* gm = gmod + 2 * 6144;
#pragma unroll
            for (int bj = 0; bj < 2; ++bj) { const int col = colb + bj * HALF; const f32x4 g0 = *(const f32x4*)(gm + col), g1 = *(const f32x4*)(gm + col + 4);
#pragma unroll
                for (int ai = 0; ai < 2; ++ai)
#pragma unroll
                    for (int m = 0; m < 4; ++m) { const size_t off = (size_t)(row0 + ai * HALF + m * 16) * DM + col;
                        *(f32x4*)(pp + off) = g0 * acc[ai][bj][m][0]; *(f32x4*)(pp + off + 4) = g1 * acc[ai][bj][m][1]; } }
            return;
        }
        if (EK == EK_RES) {
            const bool isctx = u.pm >= 64;
            const float* xi = isctx ? xin_ctx - (size_t)NLAT * DM : xin_lat; float* xo = isctx ? xout_ctx - (size_t)NLAT * DM : xout_lat;
            const float* gm = gmod + (u.pm < 32 ? 0 : (u.pm < 64 ? 1 : 2)) * 6144;
#pragma unroll
            for (int bj = 0; bj < 2; ++bj) { const int col = colb + bj * HALF; const f32x4 g0 = *(const f32x4*)(gm + col), g1 = *(const f32x4*)(gm + col + 4);
#pragma unroll
                for (int ai = 0; ai < 2; ++ai)
#pragma unroll
                    for (int m = 0; m < 4; ++m) { const size_t off = (size_t)(row0 + ai * HALF + m * 16) * DM + col;
                        const f32x4 x0 = *(const f32x4*)(xi + off), x1 = *(const f32x4*)(xi + off + 4);
                        *(f32x4*)(xo + off) = x0 + g0 * acc[ai][bj][m][0]; *(f32x4*)(xo + off + 4) = x1 + g1 * acc[ai][bj][m][1]; } }
            return;
        }
        bf16_t* base; int ld, col0 = colb;
        if (EK == EK_QKV) { if (u.pn < 7) { base = o0; ld = PQ_LD; if (u.pn >= 4) col0 = colb + 512; } else { base = o1; ld = PKV_LD; col0 = colb - 7 * BM; } }
        else if (EK == EK_UKV) { if (u.pn < 2) { base = o0; ld = 512; } else { base = o1; ld = 512; col0 = colb - 512; } }
        else if (EK == EK_GATE) { base = o0; ld = GATE_LD; }
        else if (EK == EK_MERGE) { base = o0; ld = DM; }
        else { base = o0; ld = DFF; }
#pragma unroll
        for (int ai = 0; ai < 2; ++ai)
#pragma unroll
            for (int m = 0; m < 4; ++m) { const int row = row0 + ai * HALF + m * 16; bf16_t* rowp = base + (size_t)row * ld + col0;
#pragma unroll
                for (int bj = 0; bj < 2; ++bj) { f32x4 v0 = acc[ai][bj][m][0], v1 = acc[ai][bj][m][1];
                    if (EK == EK_GATE) {
#pragma unroll
                        for (int e = 0; e < 4; ++e) { v0[e] = fast_sigmoid(v0[e]); v1[e] = fast_sigmoid(v1[e]); } }
                    if (EK == EK_SQRELU) {
#pragma unroll
                        for (int e = 0; e < 4; ++e) { const float a = fmaxf(v0[e], 0.f), b = fmaxf(v1[e], 0.f); v0[e] = a * a; v1[e] = b * b; } }
                    if (EK == EK_MERGE) { const u32x4 g = *(const u32x4*)(gates + gate_tile(2, u.pm, u.pn) + (size_t)((ai * 4 + m) * 2 + bj) * 4096 + ((((wr * 4 + wc) * 64) + fq * 16 + fr) * 8));
                        v0[0] *= bflo(g.x); v0[1] *= bfhi(g.x); v0[2] *= bflo(g.y); v0[3] *= bfhi(g.y); v1[0] *= bflo(g.z); v1[1] *= bfhi(g.z); v1[2] *= bflo(g.w); v1[3] *= bfhi(g.w); }
                    u32x4 w; w.x = pk2(v0[0], v0[1]); w.y = pk2(v0[2], v0[3]); w.z = pk2(v1[0], v1[1]); w.w = pk2(v1[2], v1[3]);
                    if (EK == EK_GATE) *(u32x4*)(o0 + gate_tile(u.pn >> 2, u.pm, u.pn & 3) + (size_t)((ai * 4 + m) * 2 + bj) * 4096 + ((((wr * 4 + wc) * 64) + fq * 16 + fr) * 8)) = w;
                    else *(u32x4*)(rowp + bj * HALF) = w; } }
    }
};
}

__device__ __forceinline__ int crow(int r, int hi) { return (r & 3) + 8 * (r >> 2) + 4 * hi; }
__device__ __forceinline__ float max3f(float a, float b, float c) { return fmaxf(fmaxf(a, b), c); }
__device__ __forceinline__ s16x4 vtr(const LAS unsigned char* p) { return __builtin_bit_cast(s16x4, __builtin_amdgcn_ds_read_tr16_b64_v4i16((LAS s16x4*)p)); }

template <int DK, bool NA>
__device__ __forceinline__ void attn_unit(const int tid, LAS unsigned char* lds,
        const bf16_t* __restrict__ q, bf16_t* o,
        const bf16_t* __restrict__ kbase, const bf16_t* __restrict__ vbase, const bf16_t* __restrict__ krbase,
        const int row_lat, const int row_ctx, int n_lat, float c, const float* __restrict__ rpb, int r0, int rs0, const bool nomax = false) {
    constexpr int KP = DK * 2 + 16, VP = 192, KBUF = 64 * KP, VBUF = 64 * VP, ND = DK / 16;
    constexpr bool VPF = false, KPF = false; constexpr int qld = PQ_LD, old_ = PQ_LD, kld = (DK == 96) ? 512 : PKV_LD, vld = kld;
    const int lane = tid & 63, r32 = lane & 31, hi = lane >> 5, wid = __builtin_amdgcn_readfirstlane(tid >> 6);
    LAS unsigned char* Ks = lds; LAS unsigned char* Vs = lds + 2 * KBUF;
    LAS float* rp = (LAS float*)(lds + 2 * KBUF + 2 * VBUF) + 64;
    const int NT = n_lat + 4;
    const int lkey = tid >> 3, lpart = tid & 7, lkey2 = tid >> 3, lpart2 = tid & 7;
    const unsigned kdst = lkey * KP + lpart * 16, vdst = lkey * VP + lpart * 16, k2dst = lkey2 * KP + 128 + lpart2 * 8;
    u32x4 kregA, vregA, kregB, vregB; u32x2 kreg2A, kreg2B;
#define ATT_LOADK(t, kreg, kreg2) do { const int tk_ = (t); const int rr_ = (tk_ < n_lat) ? row_lat + tk_ * 64 : row_ctx + (tk_ - n_lat) * 64; \
        kreg = *(const u32x4*)(kbase + (size_t)(rr_ + lkey) * kld + lpart * 8); \
        if (DK == 96) kreg2 = *(const u32x2*)(krbase + (size_t)(rr_ + lkey2) * 32 + lpart2 * 4); } while (0)
#define ATT_LOADV(t, vreg) do { const int tv_ = (t); const int rr_ = (tv_ < n_lat) ? row_lat + tv_ * 64 : row_ctx + (tv_ - n_lat) * 64; \
        vreg = *(const u32x4*)(vbase + (size_t)(rr_ + lkey) * vld + lpart * 8); } while (0)
#define ATT_STOREK(buf, kreg, kreg2) do { *(LAS u32x4*)(Ks + (buf) * KBUF + kdst) = kreg; if (DK == 96) *(LAS u32x2*)(Ks + (buf) * KBUF + k2dst) = kreg2; } while (0)
#define ATT_STOREV(buf, vreg) do { *(LAS u32x4*)(Vs + (buf) * VBUF + vdst) = vreg; } while (0)
#define ATT_MFMA __builtin_amdgcn_mfma_f32_32x32x16_bf16
#define ATT_KLOAD(kbuf) do { const LAS unsigned char* Kb_ = Ks + (kbuf) * KBUF + kaddr; \
        _Pragma("unroll") for (int d0 = 0; d0 < ND; ++d0) { kf[d0][0] = *(const LAS bf16x8*)(Kb_ + d0 * 32); kf[d0][1] = *(const LAS bf16x8*)(Kb_ + 32 * KP + d0 * 32); } } while (0)
#define ATT_QK(P0, P1, kbuf, INIT) do { if (!KPF) ATT_KLOAD(kbuf); \
        _Pragma("unroll") for (int d0 = 0; d0 < ND; ++d0) { \
            if (d0 == 0) { P0 = ATT_MFMA(kf[0][0], qf[0], INIT, 0, 0, 0); P1 = ATT_MFMA(kf[0][1], qf[0], INIT, 0, 0, 0); } \
            else { P0 = ATT_MFMA(kf[d0][0], qf[d0], P0, 0, 0, 0); P1 = ATT_MFMA(kf[d0][1], qf[d0], P1, 0, 0, 0); } } } while (0)
    ATT_LOADK(0, kregA, kreg2A); ATT_LOADV(0, vregA);
    bf16x8 qf[ND];
    { const bf16_t* qrow = q + (size_t)(wid * 32 + r32) * qld + hi * 8;
#pragma unroll
      for (int d0 = 0; d0 < ND; ++d0) { const u32x4 w = *(const u32x4*)(qrow + d0 * 16); u32x4 s;
          s.x = pk2(bflo(w.x) * c, bfhi(w.x) * c); s.y = pk2(bflo(w.y) * c, bfhi(w.y) * c); s.z = pk2(bflo(w.z) * c, bfhi(w.z) * c); s.w = pk2(bflo(w.w) * c, bfhi(w.w) * c);
          qf[d0] = __builtin_bit_cast(bf16x8, s); } }
    int qc = 0, cs = 0, rq = 0, rsq = 0;
    if (NA) { qc = 32 * (wid & 1) + r32; cs = min(max(qc - 8, 0), 48); rq = r0 + (wid >> 1); rsq = min(max(rq - 4, 0), 120);
        if (tid < 465) rp[tid] = rpb[tid] * LOG2E; }
    ATT_STOREK(0, kregA, kreg2A); ATT_STOREV(0, vregA);
    ATT_LOADK(1, kregA, kreg2A); ATT_STOREK(1, kregA, kreg2A);
    ATT_LOADK(2, kregA, kreg2A); ATT_LOADV(1, vregA);
    __syncthreads();
    const int g_ = lane >> 4, q_ = (lane & 15) >> 2, p_ = lane & 3;
    const unsigned vaddr = (4 * (g_ >> 1) + q_) * VP + (16 * (g_ & 1) + 4 * p_) * 2;
    const unsigned kaddr = r32 * KP + hi * 16;
    float l_run = 0.f, mxa = 0.f, mxb = 0.f; bool first = true;
    f32x16 o0 = {}, o1 = {}, negm = {};
    f32x16 sa0 = {}, sa1 = {}, sb0 = {}, sb1 = {};
#define ATT_BIASMAX(P0, P1, MX, tt) do { const int tb_ = (tt); \
        if (NA && tb_ < n_lat) { const int bi_ = (rs0 + tb_ - rq + 7) * 31 + 15 - qc; \
            _Pragma("unroll") for (int r = 0; r < 16; ++r) { const int cj = crow(r, hi); \
                P0[r] = ((unsigned)(cj - cs) < 16u) ? P0[r] + rp[bi_ + cj] : -INFINITY; \
                P1[r] = ((unsigned)(cj + 32 - cs) < 16u) ? P1[r] + rp[bi_ + cj + 32] : -INFINITY; } } \
        if (!NA && nomax) { MX = 0.f; break; }                       \
        float mx_ = max3f(P0[0], P0[1], P1[0]), mb_ = max3f(P0[2], P0[3], P1[1]); mx_ = max3f(mx_, P1[2], P1[3]); \
        _Pragma("unroll") for (int r = 4; r < 16; r += 4) { mx_ = max3f(mx_, P0[r], P0[r + 1]); mb_ = max3f(mb_, P0[r + 2], P0[r + 3]); mx_ = max3f(mx_, P1[r], P1[r + 1]); mb_ = max3f(mb_, P1[r + 2], P1[r + 3]); } \
        MX = swap_max(fmaxf(mx_, mb_)); } while (0)
#define ATT_ACTIVE(tt) (!(NA && (tt) < n_lat) || ((rs0 + (tt) >= rsq) && (rs0 + (tt) < rsq + 8)))
    bf16x8 kf[ND][2];
    if (ATT_ACTIVE(0)) { if (KPF) ATT_KLOAD(0); ATT_QK(sa0, sa1, 0, negm); ATT_BIASMAX(sa0, sa1, mxa, 0); }
    __syncthreads();
#define ATT_ITER(t, PA0, PA1, PB0, PB1, MXA, MXB, KI, K2I, VI, KS, K2S, VS) do { const int t_ = (t); const bool hk_ = t_ + 2 < NT, hv_ = t_ + 1 < NT; \
        if (t_ + 3 < NT) ATT_LOADK(t_ + 3, KI, K2I);                  \
        if (t_ + 2 < NT) ATT_LOADV(t_ + 2, VI); \
        const bool act_ = ATT_ACTIVE(t_), actn_ = NA ? (hv_ && ATT_ACTIVE(t_ + 1)) : true; \
        if (act_) { if (first || __any(MXA > 8.f)) {                 \
                const float d_ = first ? MXA : fmaxf(MXA, 0.f), alpha_ = __builtin_amdgcn_exp2f(-d_); \
                PA0 -= d_; PA1 -= d_; negm -= d_; l_run *= alpha_; o0 *= alpha_; o1 *= alpha_; first = false; } } \
        s16x4 vq_[4][4]; \
        if (KPF && actn_) ATT_KLOAD((t_ + 1) & 1); \
        if (VPF && act_) { const LAS unsigned char* Vb_ = Vs + (t_ & 1) * VBUF + vaddr; \
            _Pragma("unroll") for (int s = 0; s < 4; ++s) { const int ro_ = (16 * (s & 1) + 32 * (s >> 1)) * VP; \
                vq_[s][0] = vtr(Vb_ + ro_); vq_[s][1] = vtr(Vb_ + ro_ + 8 * VP); vq_[s][2] = vtr(Vb_ + ro_ + 64); vq_[s][3] = vtr(Vb_ + ro_ + 8 * VP + 64); } } \
        if (KPF) __builtin_amdgcn_sched_barrier(0); \
        __builtin_amdgcn_s_setprio(1); \
        if (actn_) ATT_QK(PB0, PB1, (t_ + 1) & 1, negm); \
        if (act_) { \
            float ps_ = 0.f; \
            _Pragma("unroll") for (int r = 0; r < 16; ++r) { PA0[r] = __builtin_amdgcn_exp2f(PA0[r]); PA1[r] = __builtin_amdgcn_exp2f(PA1[r]); ps_ += PA0[r] + PA1[r]; } \
            l_run += ps_; \
            bf16x8 pa_[4]; \
            _Pragma("unroll") for (int s = 0; s < 2; ++s) { u32x4 w0, w1; \
                w0.x = pk2(PA0[8 * s + 0], PA0[8 * s + 1]); w0.y = pk2(PA0[8 * s + 2], PA0[8 * s + 3]); w0.z = pk2(PA0[8 * s + 4], PA0[8 * s + 5]); w0.w = pk2(PA0[8 * s + 6], PA0[8 * s + 7]); \
                w1.x = pk2(PA1[8 * s + 0], PA1[8 * s + 1]); w1.y = pk2(PA1[8 * s + 2], PA1[8 * s + 3]); w1.z = pk2(PA1[8 * s + 4], PA1[8 * s + 5]); w1.w = pk2(PA1[8 * s + 6], PA1[8 * s + 7]); \
                pa_[s] = __builtin_bit_cast(bf16x8, w0); pa_[2 + s] = __builtin_bit_cast(bf16x8, w1); } \
            const LAS unsigned char* Vc_ = Vs + (t_ & 1) * VBUF + vaddr; \
            _Pragma("unroll") for (int s = 0; s < 4; ++s) { const int ro_ = (16 * (s & 1) + 32 * (s >> 1)) * VP; \
                if (!VPF) { vq_[s][0] = vtr(Vc_ + ro_); vq_[s][1] = vtr(Vc_ + ro_ + 8 * VP); vq_[s][2] = vtr(Vc_ + ro_ + 64); vq_[s][3] = vtr(Vc_ + ro_ + 8 * VP + 64); } \
                const s16x4 a0 = vq_[s][0], a1 = vq_[s][1], b0 = vq_[s][2], b1 = vq_[s][3]; \
                const bf16x8 vf0 = {a0[0], a0[1], a0[2], a0[3], a1[0], a1[1], a1[2], a1[3]}, vf1 = {b0[0], b0[1], b0[2], b0[3], b1[0], b1[1], b1[2], b1[3]}; \
                o0 = ATT_MFMA(vf0, pa_[s], o0, 0, 0, 0); o1 = ATT_MFMA(vf1, pa_[s], o1, 0, 0, 0); } \
        } \
        if (actn_) ATT_BIASMAX(PB0, PB1, MXB, t_ + 1); \
        __builtin_amdgcn_s_setprio(0); \
        if (hk_) ATT_STOREK(t_ & 1, KS, K2S); \
        if (hv_) ATT_STOREV((t_ + 1) & 1, VS); \
        asm volatile("s_waitcnt lgkmcnt(0)\n\ts_barrier" ::: "memory"); } while (0)
    for (int t = 0; t < NT; t += 2) {
        ATT_ITER(t, sa0, sa1, sb0, sb1, mxa, mxb, kregB, kreg2B, vregB, kregA, kreg2A, vregA);
        if (t + 1 < NT) ATT_ITER(t + 1, sb0, sb1, sa0, sa1, mxb, mxa, kregA, kreg2A, vregA, kregB, kreg2B, vregB);
    }
    const float inv = 1.f / swap_sum(l_run);
    bf16_t* orow = o + (size_t)(wid * 32 + r32) * old_ + 4 * hi;
#pragma unroll
    for (int a = 0; a < 4; ++a) {
        u32x2 w0, w1;
        w0.x = pk2(o0[4 * a] * inv, o0[4 * a + 1] * inv); w0.y = pk2(o0[4 * a + 2] * inv, o0[4 * a + 3] * inv);
        w1.x = pk2(o1[4 * a] * inv, o1[4 * a + 1] * inv); w1.y = pk2(o1[4 * a + 2] * inv, o1[4 * a + 3] * inv);
        *(u32x2*)(orow + 8 * a) = w0; *(u32x2*)(orow + 32 + 8 * a) = w1;
    }
#undef ATT_LOADK
#undef ATT_LOADV
#undef ATT_STOREK
#undef ATT_STOREV
#undef ATT_QK
#undef ATT_KLOAD
#undef ATT_ITER
#undef ATT_BIASMAX
#undef ATT_ACTIVE
#undef ATT_MFMA
}


#define XB_TMO      128
#define XB_XCNT(j)  (256  + 64 * (j))
#define XB_XSUB(j)  (1280 + 64 * (j))
#define XB_XGEN(j)  (2304 + 64 * (j))
#define XB_TOP      3328
#define XB_TOPGEN   3392
#define XCD_BAR_WORDS 3456
#define XB_SPIN_CAP (1u << 20)
__device__ __forceinline__ unsigned xb_ld(unsigned* p)              { return __hip_atomic_load(p, __ATOMIC_RELAXED, __HIP_MEMORY_SCOPE_AGENT); }
__device__ __forceinline__ unsigned xb_add(unsigned* p, unsigned v) { return __hip_atomic_fetch_add(p, v, __ATOMIC_RELAXED, __HIP_MEMORY_SCOPE_AGENT); }
__device__ __forceinline__ unsigned xb_xcc_id() { return (unsigned)__builtin_amdgcn_s_getreg((3 << 11) | 20) & 0xFu; }
#define XB_SPIN(cond, bar) do { unsigned _sp = 0; while (cond) { __builtin_amdgcn_s_sleep(1); \
    if ((++_sp & 255u) == 0u) { if (xb_ld(&(bar)[XB_TMO])) break; if (_sp > XB_SPIN_CAP) { atomicAdd(&(bar)[XB_TMO], 1u); break; } } } } while (0)
struct XcdBarrier { unsigned* bar; unsigned x; volatile LAS unsigned* st; };
__device__ __forceinline__ XcdBarrier xcd_barrier_post(unsigned* bar, volatile LAS unsigned* st) {
    XcdBarrier b; b.bar = bar; b.x = xb_xcc_id(); b.st = st;
    if (threadIdx.x == 0) (void)xb_add(&bar[XB_XCNT(b.x)], 1u);
    return b;
}
__device__ __forceinline__ void xcd_barrier_complete(unsigned* bar, unsigned x, unsigned& nloc, unsigned& nx) {
    const unsigned G = gridDim.x * gridDim.y * gridDim.z;
    unsigned sum, cnt, mine, sp = 0u;
    for (;;) {
        sum = 0u; cnt = 0u; mine = 0u;
#pragma unroll
        for (unsigned j = 0; j < 16; ++j) { const unsigned c = xb_ld(&bar[XB_XCNT(j)]); sum += c; cnt += (c > 0u) ? 1u : 0u; mine = (j == x) ? c : mine; }
        if (sum == G) break;
        __builtin_amdgcn_s_sleep(1);
        if ((++sp & 255u) == 0u) { if (xb_ld(&bar[XB_TMO])) break; if (sp > XB_SPIN_CAP) { atomicAdd(&bar[XB_TMO], 1u); break; } }
    }
    nloc = mine > 0u ? mine : 1u; nx = cnt > 0u ? cnt : 1u;
}
__device__ __forceinline__ void xcd_barrier(const XcdBarrier& b) {
    asm volatile("s_waitcnt vmcnt(0)" ::: "memory");
    __syncthreads();
    if (threadIdx.x == 0) {
        unsigned* bar = b.bar;
        __builtin_amdgcn_s_waitcnt(0);
        unsigned nloc = b.st[0], nx = b.st[1];
        if (nloc == 0u) { xcd_barrier_complete(bar, b.x, nloc, nx); b.st[0] = nloc; b.st[1] = nx; }
        const unsigned old = xb_add(&bar[XB_XSUB(b.x)], 1u);
        const unsigned gen = old / nloc;
        if (old + 1u == (gen + 1u) * nloc) {
            __builtin_amdgcn_fence(__ATOMIC_RELEASE, "agent");
            asm volatile("s_waitcnt vmcnt(0)" ::: "memory");
            const unsigned og = xb_add(&bar[XB_TOP], 1u);
            const unsigned tg = og / nx;
            if (og + 1u == (tg + 1u) * nx) xb_add(&bar[XB_TOPGEN], 1u);
            else XB_SPIN(xb_ld(&bar[XB_TOPGEN]) == tg, bar);
            __builtin_amdgcn_fence(__ATOMIC_ACQUIRE, "agent");
            xb_add(&bar[XB_XGEN(b.x)], 1u);
            asm volatile("s_waitcnt vmcnt(0)" ::: "memory");
        } else {
            XB_SPIN(xb_ld(&bar[XB_XGEN(b.x)]) == gen, bar);
            __builtin_amdgcn_fence(__ATOMIC_ACQUIRE, "agent");
            asm volatile("s_waitcnt vmcnt(0)" ::: "memory");
        }
    }
    __syncthreads();
}

struct Args { const float* in[22]; float* out; unsigned char* ws; int ph_lo, ph_hi; };
#define AIN(k) (a.in[(k) + zofs])

__device__ __forceinline__ void wconv(const float* __restrict__ W, int K, int ldw, int c0, int n, bf16_t* __restrict__ Wt, int r0, int ldt, int koff, LAS float* sm, int& rot, int G, int bid, const int tid) {
    const int nkt = K / 128, nnt = n / 32, ntiles = nkt * nnt, ngroups = (ntiles + 3) >> 2;
    int start = bid - rot; if (start < 0) start += G;
    int par = 0;
    for (int g = start; g < ngroups; g += G) {
        LAS float* smb = sm + par * (4 * 128 * 33); par ^= 1;
        f32x4 v[4][2];
#pragma unroll
        for (int j = 0; j < 4; ++j) { const int t = g * 4 + j;
            if (t < ntiles) { const int kt = t / nnt, ntile = t - kt * nnt, k0 = kt * 128, n0 = ntile * 32;
#pragma unroll
                for (int i = 0; i < 2; ++i) v[j][i] = __builtin_nontemporal_load((const f32x4*)(W + (size_t)(k0 + (tid >> 3) + 64 * i) * ldw + c0 + n0 + (tid & 7) * 4)); } }
#pragma unroll
        for (int j = 0; j < 4; ++j) { const int t = g * 4 + j;
            if (t < ntiles) {
#pragma unroll
                for (int i = 0; i < 2; ++i) { LAS float* p = smb + j * (128 * 33) + ((tid >> 3) + 64 * i) * 33 + (tid & 7) * 4; p[0] = v[j][i][0]; p[1] = v[j][i][1]; p[2] = v[j][i][2]; p[3] = v[j][i][3]; } } }
        __syncthreads();
#pragma unroll
        for (int j = 0; j < 4; ++j) { const int t = g * 4 + j;
            if (t < ntiles) { const int kt = t / nnt, ntile = t - kt * nnt, k0 = kt * 128, n0 = ntile * 32;
                const LAS float* p = smb + j * (128 * 33); const int nn = tid >> 4, k8 = (tid & 15) * 8; u32x4 w;
                w.x = pk2(p[(k8 + 0) * 33 + nn], p[(k8 + 1) * 33 + nn]); w.y = pk2(p[(k8 + 2) * 33 + nn], p[(k8 + 3) * 33 + nn]);
                w.z = pk2(p[(k8 + 4) * 33 + nn], p[(k8 + 5) * 33 + nn]); w.w = pk2(p[(k8 + 6) * 33 + nn], p[(k8 + 7) * 33 + nn]);
                *(u32x4*)(Wt + (size_t)(r0 + n0 + nn) * ldt + koff + k0 + k8) = w; } }
    }
    __syncthreads();
    rot = (rot + ngroups) % G;
}

__device__ __forceinline__ void convert_weights(const Args& a, const int zofs, int l, LAS float* sm, int G, int bid, const int tid, const int groups = 7) {
    unsigned char* ws = a.ws; int rot = 0;
    if (groups & 1) {
    bf16_t* WINT = (bf16_t*)(ws + WS_WINT); const float* win = AIN(8) + (size_t)l * DM * WIN_COLS;
    wconv(win, DM, WIN_COLS, 0, 512, WINT, 0, DM, 0, sm, rot, G, bid, tid);
    wconv(win, DM, WIN_COLS, 768, 512, WINT, 512, DM, 0, sm, rot, G, bid, tid);
    wconv(win, DM, WIN_COLS, 2304, 768, WINT, 1024, DM, 0, sm, rot, G, bid, tid);
    wconv(win, DM, WIN_COLS, 512, 256, WINT, 1792, DM, 0, sm, rot, G, bid, tid);
    wconv(win, DM, WIN_COLS, 1280, 1024, WINT, 2048, DM, 0, sm, rot, G, bid, tid);
    wconv(win, DM, WIN_COLS, 3072, 288, WINT, 3072, DM, 0, sm, rot, G, bid, tid);
    wconv(win, DM, WIN_COLS, 3360, 3072, WINT, 3584, DM, 0, sm, rot, G, bid, tid);
    for (int i = bid * 512 + tid; i < 224 * DM / 8; i += G * 512) *(u32x4*)(WINT + (size_t)3360 * DM + (size_t)i * 8) = (u32x4){0u, 0u, 0u, 0u};
    bf16_t* WUKVT = (bf16_t*)(ws + WS_WUKVT);
    wconv(AIN(13) + (size_t)l * 256 * 512, 256, 512, 0, 512, WUKVT, 0, 256, 0, sm, rot, G, bid, tid);
    wconv(AIN(14) + (size_t)l * 256 * 512, 256, 512, 0, 512, WUKVT, 512, 256, 0, sm, rot, G, bid, tid);
    }
    if (groups & 2) {
    bf16_t* WO3T = (bf16_t*)(ws + WS_WO3T);
    wconv(AIN(15) + (size_t)l * 512 * DM, 512, DM, 0, DM, WO3T, 0, 1536, 0, sm, rot, G, bid, tid);
    wconv(AIN(16) + (size_t)l * 512 * DM, 512, DM, 0, DM, WO3T, 0, 1536, 512, sm, rot, G, bid, tid);
    wconv(AIN(17) + (size_t)l * 512 * DM, 512, DM, 0, DM, WO3T, 0, 1536, 1024, sm, rot, G, bid, tid);
    wconv(AIN(18) + (size_t)l * DM * DM, DM, DM, 0, DM, (bf16_t*)(ws + WS_WOUTT), 0, DM, 0, sm, rot, G, bid, tid);
    }
    if (groups & 4) {
    wconv(AIN(19) + (size_t)l * DM * DFF, DM, DFF, 0, DFF, (bf16_t*)(ws + WS_W1T), 0, DM, 0, sm, rot, G, bid, tid);
    wconv(AIN(20) + (size_t)l * DFF * DM, DFF, DM, 0, DM, (bf16_t*)(ws + WS_W2T), 0, DFF, 0, sm, rot, G, bid, tid);
    }
}

__device__ __forceinline__ void norm_mod(const float* xlat, const float* xctx, int nrows, const float* __restrict__ gain, const float* __restrict__ mod, int sh_i, int sc_i, bf16_t* H, int G, int bid, const int tid,
                                         const float* part = nullptr, int nparts = 0, float* xc_out = nullptr) {
    const int lane = tid & 63, wid = tid >> 6;
    for (int row0 = bid * 8 + wid; row0 < nrows; row0 += 2 * G * 8) {
        f32x4 v[2][4]; float ss[2] = {0.f, 0.f}; int rows[2]; bool ok[2];
#pragma unroll
        for (int j = 0; j < 2; ++j) { rows[j] = row0 + j * G * 8; ok[j] = rows[j] < nrows; const int row = ok[j] ? rows[j] : row0;
            const float* xr = row < NLAT ? xlat + (size_t)row * DM : xctx + (size_t)(row - NLAT) * DM;
#pragma unroll
            for (int i = 0; i < 4; ++i) v[j][i] = *(const f32x4*)(xr + lane * 4 + 256 * i); }
#pragma unroll
        for (int j = 0; j < 2; ++j) { const int row = ok[j] ? rows[j] : row0;
            if (nparts > 0 && row >= NLAT) {
                for (int p = 0; p < nparts; ++p) { const float* pr = part + ((size_t)p * NCTX + (row - NLAT)) * DM;
#pragma unroll
                    for (int i = 0; i < 4; ++i) v[j][i] += *(const f32x4*)(pr + lane * 4 + 256 * i); }
                if (xc_out && ok[j]) {
#pragma unroll
                    for (int i = 0; i < 4; ++i) *(f32x4*)(xc_out + (size_t)(row - NLAT) * DM + lane * 4 + 256 * i) = v[j][i]; }
            }
#pragma unroll
            for (int i = 0; i < 4; ++i) ss[j] += v[j][i][0] * v[j][i][0] + v[j][i][1] * v[j][i][1] + v[j][i][2] * v[j][i][2] + v[j][i][3] * v[j][i][3]; }
        ss[0] = wave_sum(ss[0]); ss[1] = wave_sum(ss[1]);
#pragma unroll
        for (int j = 0; j < 2; ++j) { if (!ok[j]) continue; const int row = rows[j];
            const float* mr = mod + (row < SEQ ? 0 : (row < NLAT ? 1 : 2)) * 6144;
            const float rstd = rsqrtf(ss[j] * (1.f / DM) + EPS);
#pragma unroll
            for (int i = 0; i < 4; ++i) { const int col = lane * 4 + 256 * i;
                const f32x4 g = *(const f32x4*)(gain + col), sh = *(const f32x4*)(mr + sh_i * DM + col), sc = *(const f32x4*)(mr + sc_i * DM + col);
                f32x4 h;
#pragma unroll
                for (int e = 0; e < 4; ++e) h[e] = (v[j][i][e] * rstd * g[e]) * (1.f + sc[e]) + sh[e];
                u32x2 w; w.x = pk2(h[0], h[1]); w.y = pk2(h[2], h[3]);
                *(u32x2*)(H + (size_t)row * DM + col) = w; } }
    }
}

__global__ void __launch_bounds__(512, 2) fwd(Args a) {
    extern __shared__ __attribute__((aligned(16))) unsigned char lds_raw[];
    LAS unsigned char* lds = (LAS unsigned char*)lds_raw;
    cg::grid_group grid = cg::this_grid();
    volatile LAS unsigned* xst = (volatile LAS unsigned*)(lds + LDS_BYTES - 16);
    if (threadIdx.x == 0) { xst[0] = 0u; xst[1] = 0u; }
    __syncthreads();
    bool rep2 = false, need_sync = false;
    for (int ph = a.ph_lo; ph < a.ph_hi; ++ph) {
        if (need_sync) { if (ph == a.ph_lo + 1 && !rep2) { grid.sync(); (void)xcd_barrier_post((unsigned*)(a.ws + WS_BAR), (volatile LAS unsigned*)(lds + LDS_BYTES - 16)); }     else { XcdBarrier xb; xb.bar = (unsigned*)(a.ws + WS_BAR); xb.x = xb_xcc_id(); xb.st = (volatile LAS unsigned*)(lds + LDS_BYTES - 16); xcd_barrier(xb); } }
        need_sync = true;
        GAS unsigned char* wsg = (GAS unsigned char*)a.ws; asm volatile("" : "+s"(wsg));
        unsigned char* ws = (unsigned char*)wsg;
        int zofs = 0; asm volatile("" : "+s"(zofs));
        int G = gridDim.x, bid = blockIdx.x, tid = threadIdx.x; asm volatile("" : "+s"(G), "+s"(bid), "+v"(tid));
        const int lane = tid & 63, wid = __builtin_amdgcn_readfirstlane(tid >> 6);
        float* MOD = (float*)(ws + WS_MOD);
        f32x2* TABA = (f32x2*)(ws + WS_TABA); f32x2* TABM = (f32x2*)(ws + WS_TABM);
        float* XC = (float*)(ws + WS_XC);
        bf16_t* H = (bf16_t*)(ws + WS_H); bf16_t* PQ = (bf16_t*)(ws + WS_PQ); bf16_t* PKV = (bf16_t*)(ws + WS_PKV);
        bf16_t* CKV = (bf16_t*)(ws + WS_CKV); bf16_t* MLAKN = (bf16_t*)(ws + WS_MLAKN); bf16_t* MLAV = (bf16_t*)(ws + WS_MLAV); bf16_t* KR = (bf16_t*)(ws + WS_KR);
        bf16_t* GATES = (bf16_t*)(ws + WS_GATES); bf16_t* HID = (bf16_t*)(ws + WS_HID); float* PART = (float*)(ws + WS_CKV);
        const bf16_t* W1T = (const bf16_t*)(ws + WS_W1T); const bf16_t* W2T = (const bf16_t*)(ws + WS_W2T); const bf16_t* WINT = (const bf16_t*)(ws + WS_WINT);
        const bf16_t* WUKVT = (const bf16_t*)(ws + WS_WUKVT); const bf16_t* WO3T = (const bf16_t*)(ws + WS_WO3T); const bf16_t* WOUTT = (const bf16_t*)(ws + WS_WOUTT);

        if (ph == 0) {
            if (bid == 0) for (int i = tid; i < XCD_BAR_WORDS; i += 512) ((unsigned*)(ws + WS_BAR))[i] = 0u;
            convert_weights(a, zofs, 0, (LAS float*)lds, G, bid, tid, G == 256 ? 3 : 7);
            for (int u = bid; u < 192; u += G) {
                const int l = u / 96, j0 = (u % 96) * 64;
                LAS float* sv = (LAS float*)lds; LAS float* red = sv + 3 * 1024;
                for (int i = tid; i < 3 * 1024; i += 512) { const int r = i >> 10, k = i & 1023; const float cv = r < 2 ? AIN(1)[r * DM + k] : AIN(3)[k]; sv[i] = cv / (1.f + __expf(-cv)); }
                __syncthreads();
                const int col = tid & 63, kq = tid >> 6;
                const float* wp = AIN(4) + (size_t)l * DM * 6144 + (size_t)(kq * 128) * 6144 + j0 + col;
                float a0 = 0.f, a1 = 0.f, a2 = 0.f;
#pragma unroll 8
                for (int k = 0; k < 128; ++k) { const float w = wp[(size_t)k * 6144]; a0 += sv[kq * 128 + k] * w; a1 += sv[1024 + kq * 128 + k] * w; a2 += sv[2048 + kq * 128 + k] * w; }
                red[(kq * 3 + 0) * 64 + col] = a0; red[(kq * 3 + 1) * 64 + col] = a1; red[(kq * 3 + 2) * 64 + col] = a2;
                __syncthreads();
                if (tid < 192) { const int r = tid >> 6, cl = tid & 63; float s = 0.f;
#pragma unroll
                    for (int q = 0; q < 8; ++q) s += red[(q * 3 + r) * 64 + cl];
                    MOD[(l * 3 + r) * 6144 + j0 + cl] = s + AIN(5)[l * 6144 + j0 + cl]; }
                __syncthreads();
            }
            for (int i = bid * 512 + tid; i < SEQ * 48; i += G * 512) {
                const int t = i / 48, f = i - t * 48; const float rowf = (float)(t >> 6), colf = (float)(t & 63);
                if (f < 32) { const int fi = f & 15; const float inv = __builtin_amdgcn_exp2f(-(float)(2 * fi) * (13.287712379549449f / 32.f)); const float ang = (f < 16 ? rowf : colf) * inv; TABA[t * 32 + f] = (f32x2){__cosf(ang), __sinf(ang)}; }
                else { const int f2 = f - 32, fi = f2 & 7; const float inv = __builtin_amdgcn_exp2f(-(float)(2 * fi) * (13.287712379549449f / 16.f)); const float ang = (f2 < 8 ? rowf : colf) * inv; TABM[t * 16 + f2] = (f32x2){__cosf(ang), __sinf(ang)}; }
            }
        } else if (ph == NPH - 1) {
            const float* fg = AIN(21);
            for (int row = bid * 8 + wid; row < NLAT; row += G * 8) {
                float* xr = a.out + (size_t)row * DM; f32x4 v[4]; float ss = 0.f;
#pragma unroll
                for (int i = 0; i < 4; ++i) { v[i] = *(const f32x4*)(xr + lane * 4 + 256 * i); ss += v[i][0] * v[i][0] + v[i][1] * v[i][1] + v[i][2] * v[i][2] + v[i][3] * v[i][3]; }
                ss = wave_sum(ss); const float rstd = rsqrtf(ss * (1.f / DM) + EPS);
#pragma unroll
                for (int i = 0; i < 4; ++i) { const f32x4 g = *(const f32x4*)(fg + lane * 4 + 256 * i); *(f32x4*)(xr + lane * 4 + 256 * i) = v[i] * rstd * g; }
            }
        } else {
            const int l = (ph - 1) / 11, sp = (ph - 1) % 11;
            const float* modl = MOD + l * 3 * 6144;
            const int nMfull = 66, nMpost = (l == 0) ? 66 : 64;
            const float* xlat_in = (l == 0) ? AIN(0) : a.out; const float* xctx_in = (l == 0) ? AIN(2) : XC;
            if (sp == 0) {
                if (l == 1) { if (G == 256) {} else if (G >= 64) convert_weights(a, zofs, 1, (LAS float*)lds, G, bid, tid, 4); else convert_weights(a, zofs, 1, (LAS float*)lds, G, bid, tid, 7); }
                norm_mod(xlat_in, xctx_in, MP, AIN(6) + l * DM, modl, 0, 1, H, G, bid, tid, PART, l == 1 ? 16 : 0, nullptr);
            } else if (sp == 1) {
                pg8::TileSched S; S.init(nMfull, 14, G, bid, H, DM, WINT, DM, DM);
                pg8::Epi<pg8::EK_QKV> E{}; E.o0 = PQ; E.o1 = PKV;
                pg8::gemm_phase(tid, lds, DM, DM, S, E);
                { int G2 = gridDim.x, b2 = blockIdx.x, t2 = threadIdx.x, z2 = 0; asm volatile("" : "+s"(G2), "+s"(b2), "+v"(t2), "+s"(z2));
                  if (G2 == 256 && b2 >= 156) convert_weights(a, z2, l, (LAS float*)lds, 100, b2 - 156, t2, 4); }
            } else if (sp == 2) {
                const float* qn = AIN(9) + l * 64; const float* kn = AIN(10) + l * 64; const float* kvn = AIN(12) + l * 256;
                const int l8 = lane & 7;
                for (int row = bid * 8 + wid; row < MP; row += G * 8) {
                    const bool lat = row < NLAT; const int t = row & (SEQ - 1);
                    bf16_t* pq = PQ + (size_t)row * PQ_LD; bf16_t* pkv = PKV + (size_t)row * PKV_LD;
                    f32x2 csa[8];
                    { const f32x4* tp = (const f32x4*)(TABA + (size_t)t * 32 + ((lane >> 2) & 1) * 16 + (lane & 1) * 8);
#pragma unroll
                      for (int e = 0; e < 4; ++e) { const f32x4 c2 = lat ? tp[e] : (f32x4){1.f, 0.f, 1.f, 0.f}; csa[2 * e] = (f32x2){c2[0], c2[1]}; csa[2 * e + 1] = (f32x2){c2[2], c2[3]}; } }
#pragma unroll
                    for (int pass = 0; pass < 2; ++pass) {
                        bf16_t* p = pass == 0 ? pq + lane * 8 : pkv + (lane & 15) * 8;
                        const float* gp = (pass == 0 ? qn : kn) + l8 * 8;
                        const u32x4 w = *(const u32x4*)p; const f32x4 g0 = *(const f32x4*)gp, g1 = *(const f32x4*)(gp + 4);
                        float v[8] = {bflo(w.x), bfhi(w.x), bflo(w.y), bfhi(w.y), bflo(w.z), bfhi(w.z), bflo(w.w), bfhi(w.w)};
                        float ss = 0.f;
#pragma unroll
                        for (int e = 0; e < 8; ++e) ss += v[e] * v[e];
                        ss += __int_as_float(__builtin_amdgcn_update_dpp(0, __float_as_int(ss), 0xB1, 0xf, 0xf, true));
                        ss += __int_as_float(__builtin_amdgcn_update_dpp(0, __float_as_int(ss), 0x4E, 0xf, 0xf, true));
                        ss += __int_as_float(__builtin_amdgcn_update_dpp(0, __float_as_int(ss), 0x141, 0xf, 0xf, true));
                        const float rstd = rsqrtf(ss * (1.f / 64.f) + EPS);
                        float o[8];
#pragma unroll
                        for (int e = 0; e < 8; ++e) { const float y = v[e] * rstd * (e < 4 ? g0[e & 3] : g1[e & 3]);
                            const float pr = __int_as_float(__builtin_amdgcn_update_dpp(0, __float_as_int(y), 0x4E, 0xf, 0xf, true));
                            o[e] = (lane & 2) ? y * csa[e][0] + pr * csa[e][1] : y * csa[e][0] - pr * csa[e][1]; }
                        u32x4 ow; ow.x = pk2(o[0], o[1]); ow.y = pk2(o[2], o[3]); ow.z = pk2(o[4], o[5]); ow.w = pk2(o[6], o[7]);
                        if (pass == 0 || lane < 16) *(u32x4*)p = ow;
                    }
                    f32x2 csm[4];
                    { const f32x4* tp = (const f32x4*)(TABM + (size_t)t * 16 + (l8 >> 2) * 8 + (l8 & 1) * 4);
#pragma unroll
                      for (int e = 0; e < 2; ++e) { const f32x4 c2 = lat ? tp[e] : (f32x4){1.f, 0.f, 1.f, 0.f}; csm[2 * e] = (f32x2){c2[0], c2[1]}; csm[2 * e + 1] = (f32x2){c2[2], c2[3]}; } }
#pragma unroll
                    for (int pass = 0; pass < 2; ++pass) {
                        bf16_t* p = pass == 0 ? pq + 1536 + (lane >> 3) * 96 + 64 + l8 * 4 : pkv + 1536 + l8 * 4;
                        const u32x2 w = *(const u32x2*)p; const float v[4] = {bflo(w.x), bfhi(w.x), bflo(w.y), bfhi(w.y)}; float o[4];
#pragma unroll
                        for (int e = 0; e < 4; ++e) { const float pr = __int_as_float(__builtin_amdgcn_update_dpp(0, __float_as_int(v[e]), 0x4E, 0xf, 0xf, true));
                            o[e] = (lane & 2) ? v[e] * csm[e][0] + pr * csm[e][1] : v[e] * csm[e][0] - pr * csm[e][1]; }
                        u32x2 ow; ow.x = pk2(o[0], o[1]); ow.y = pk2(o[2], o[3]);
                        if (pass == 0) *(u32x2*)p = ow; else if (lane < 8) *(u32x2*)(KR + (size_t)row * 32 + l8 * 4) = ow;
                    }
                    { const u32x2 w = *(const u32x2*)(pkv + 1280 + lane * 4); const float v0 = bflo(w.x), v1 = bfhi(w.x), v2 = bflo(w.y), v3 = bfhi(w.y);
                      const float ss = wave_sum(v0 * v0 + v1 * v1 + v2 * v2 + v3 * v3); const float rstd = rsqrtf(ss * (1.f / 256.f) + EPS);
                      const f32x4 g = *(const f32x4*)(kvn + lane * 4); u32x2 o; o.x = pk2(v0 * rstd * g[0], v1 * rstd * g[1]); o.y = pk2(v2 * rstd * g[2], v3 * rstd * g[3]);
                      *(u32x2*)(CKV + (size_t)row * 256 + lane * 4) = o; }
                }
            } else if (sp == 3) {
                pg8::TileSched S; S.init(nMfull, 4, G, bid, CKV, 256, WUKVT, 256, 256);
                pg8::Epi<pg8::EK_UKV> E{}; E.o0 = MLAKN; E.o1 = MLAV;
                pg8::gemm_phase(tid, lds, 256, 256, S, E);
            } else if (sp == 4) {
                const int total = 1536 + (l == 0 ? 48 : 0);
                const float c64 = 0.125f * LOG2E, c96 = 0.10206207261596577f * LOG2E;
                bool gqa_nomax; { float gqm = 0.f, gkm = 0.f; const float* qn_ = AIN(9) + l * 64; const float* kn_ = AIN(10) + l * 64;
                    for (int i = 0; i < 64; ++i) { gqm = fmaxf(gqm, fabsf(qn_[i])); gkm = fmaxf(gkm, fabsf(kn_[i])); }
                    gqa_nomax = (11.8f * gqm * gkm < 40.f); }
                for (int u = (DUPMASK && rep2) ? 512 + bid : bid; u < ((DUPMASK && rep2) ? 1024 : total); u += G) {
                    int tidu = tid; asm volatile("" : "+v"(tidu));
                    if (u < 512) {
                        const int xcd = u & 7, within = u >> 3, combo = xcd >> 1, b = combo >> 1, kvh = combo & 1, sub = (xcd & 1) * 64 + within, h = kvh * 4 + (sub >> 5), qb = sub & 31;
                        bf16_t* qp = PQ + ((size_t)b * SEQ + qb * 256) * PQ_LD + h * 64;
                        attn_unit<64, false>(tidu, lds, qp, qp, PKV + kvh * 64, PKV + 128 + kvh * 64, nullptr, b * SEQ, NLAT + b * CTXL, 128, c64, nullptr, 0, 0, gqa_nomax);
                    } else if (u < 1024) {
                        const int idx = u - 512, xcd = idx & 7, within = idx >> 3, combo = xcd * 2 + (within >> 5), b = combo >> 3, h = combo & 7, qb = within & 31;
                        bf16_t* qp = PQ + ((size_t)b * SEQ + qb * 256) * PQ_LD;
                        attn_unit<96, false>(tidu, lds, qp + 1536 + h * 96, qp + 1024 + h * 64, MLAKN + h * 64, MLAV + h * 64, KR, b * SEQ, NLAT + b * CTXL, 128, c96, nullptr, 0, 0);
                    } else if (u < 1536) {
                        const int idx = u - 1024, h = idx & 7, within = idx >> 3, b = within >> 5, rg = within & 31;
                        const int r0 = rg * 4, rs0 = min(max(r0 - 4, 0), 120), rse = min(max(r0 - 1, 0), 120) + 8;
                        bf16_t* qp = PQ + ((size_t)b * SEQ + rg * 256) * PQ_LD + 512 + h * 64;
                        attn_unit<64, true>(tidu, lds, qp, qp, PKV + 256 + h * 64, PKV + 768 + h * 64, nullptr, b * SEQ + rs0 * 64, NLAT + b * CTXL, rse - rs0, c64,
                                            AIN(11) + (size_t)(l * 8 + h) * 465, r0, rs0);
                    } else {
                        const int j = u - 1536, ty = j >> 4, b = (j >> 3) & 1, h = j & 7;
                        const int rowc = NLAT + b * CTXL;
                        bf16_t* qp = PQ + (size_t)rowc * PQ_LD;
                        if (ty == 0) { const int kvh = h >> 2;
                            attn_unit<64, false>(tidu, lds, qp + h * 64, qp + h * 64, PKV + kvh * 64, PKV + 128 + kvh * 64, nullptr, 0, rowc, 0, c64, nullptr, 0, 0);
                        } else if (ty == 1) {
                            attn_unit<64, false>(tidu, lds, qp + 512 + h * 64, qp + 512 + h * 64, PKV + 256 + h * 64, PKV + 768 + h * 64, nullptr, 0, rowc, 0, c64, nullptr, 0, 0);
                        } else {
                            attn_unit<96, false>(tidu, lds, qp + 1536 + h * 96, qp + 1024 + h * 64, MLAKN + h * 64, MLAV + h * 64, KR, 0, rowc, 0, c96, nullptr, 0, 0);
                        }
                    }
                }
            } else if (sp == 5) {
                pg8::TileSched S; S.init(nMpost, 12, G, bid, H, DM, WINT + (size_t)3584 * DM, DM, DM);
                pg8::Epi<pg8::EK_GATE> E{}; E.o0 = GATES;
                pg8::gemm_phase(tid, lds, DM, DM, S, E);
            } else if (sp == 6) {
                const bool msplit = (l == 0 && G == 256);
                pg8::TileSched S; S.init(msplit ? 64 : nMpost, 4, G, bid, PQ, PQ_LD, WO3T, 1536, 1536); if (msplit) S.split_ctx(3);
                pg8::Epi<pg8::EK_MERGE> E{}; E.o0 = H; E.gates = GATES; E.part = (float*)(ws + WS_MPART);
                pg8::gemm_phase(tid, lds, PQ_LD, 1536, S, E);
                if (l == 0) { int G2 = gridDim.x, b2 = blockIdx.x, t2 = threadIdx.x, z2 = 0; asm volatile("" : "+s"(G2), "+s"(b2), "+v"(t2), "+s"(z2));
                    if (G2 == 256) {
                        unsigned* mc = (unsigned*)(ws + WS_BAR) + 64;
                        if (b2 < 24) { asm volatile("s_waitcnt vmcnt(0)" ::: "memory"); __syncthreads();
                            if (t2 == 0) { __builtin_amdgcn_fence(__ATOMIC_RELEASE, "agent"); asm volatile("s_waitcnt vmcnt(0)" ::: "memory"); __hip_atomic_fetch_add(mc, 1u, __ATOMIC_RELAXED, __HIP_MEMORY_SCOPE_AGENT); } }
                        else { convert_weights(a, z2, 1, (LAS float*)lds, G2 - 24, b2 - 24, t2, 1);
                            if (t2 == 0) { unsigned sp_ = 0; while (__hip_atomic_load(mc, __ATOMIC_RELAXED, __HIP_MEMORY_SCOPE_AGENT) < 24u) { __builtin_amdgcn_s_sleep(2); if (++sp_ > (1u << 22)) break; }
                                __builtin_amdgcn_fence(__ATOMIC_ACQUIRE, "agent"); asm volatile("s_waitcnt vmcnt(0)" ::: "memory"); }
                            __syncthreads();
                            const float* mp = (const float*)(a.ws + WS_MPART); bf16_t* Hc = (bf16_t*)(a.ws + WS_H);
                            for (int r = b2 - 24; r < NCTX; r += G2 - 24) { const size_t o = (size_t)r * DM + t2 * 2;
                                const f32x2 p0 = *(const f32x2*)(mp + o), p1 = *(const f32x2*)(mp + (size_t)NCTX * DM + o), p2 = *(const f32x2*)(mp + (size_t)2 * NCTX * DM + o);
                                *(unsigned*)(Hc + (size_t)(NLAT + r) * DM + t2 * 2) = pk2(p0[0] + p1[0] + p2[0], p0[1] + p1[1] + p2[1]); } }
                    } else if (G2 >= 64 && b2 >= 8) convert_weights(a, z2, 1, (LAS float*)lds, G2 - 8, b2 - 8, t2, 1); }
            } else if (sp == 7) {
                pg8::TileSched S; S.init(64, 4, G, bid, H, DM, WOUTT, DM, DM); if (l == 0) S.split_ctx(8);
                pg8::Epi<pg8::EK_RES> E{}; E.xin_lat = xlat_in; E.xin_ctx = xctx_in; E.xout_lat = a.out; E.xout_ctx = XC; E.gmod = modl + 2 * DM; E.part = PART;
                pg8::gemm_phase(tid, lds, DM, DM, S, E);
            } else if (sp == 8) {
                norm_mod(a.out, l == 0 ? AIN(2) : XC, nMpost * 256, AIN(7) + l * DM, modl, 3, 4, H, G, bid, tid, PART, l == 0 ? 8 : 0, XC);
            } else if (sp == 9) {
                pg8::TileSched S; S.init(nMpost, 16, G, bid, H, DM, W1T, DM, DM);
                pg8::Epi<pg8::EK_SQRELU> E{}; E.o0 = HID;
                pg8::gemm_phase(tid, lds, DM, DM, S, E);
                if (l == 0) { int G2 = gridDim.x, b2 = blockIdx.x, t2 = threadIdx.x, z2 = 0; asm volatile("" : "+s"(G2), "+s"(b2), "+v"(t2), "+s"(z2));
                    if (G2 >= 64 && b2 >= 32) convert_weights(a, z2, 1, (LAS float*)lds, G2 - 32, b2 - 32, t2, 2); }
            } else {
                pg8::TileSched S; S.init(64, 4, G, bid, HID, DFF, W2T, DFF, DFF); if (l == 0) S.split_ctx(16);
                pg8::Epi<pg8::EK_RES> E{}; E.xin_lat = a.out; E.xin_ctx = XC; E.xout_lat = a.out; E.xout_ctx = XC; E.gmod = modl + 5 * DM; E.part = PART;
                pg8::gemm_phase(tid, lds, DFF, DFF, S, E);
            }
        }
        if (DUPMASK) {
            bool dup = false;
            if (ph == 0) dup = (DUPMASK & 1);
            else if (ph < NPH - 1) { const int l_ = (ph - 1) / 11, sp_ = (ph - 1) % 11; dup = ((DUPMASK >> (1 + sp_)) & 1) && sp_ != 2 && sp_ != 10 && !(sp_ == 7 && l_ == 1); }
            if (dup && !rep2) { rep2 = true; --ph; } else rep2 = false;
        }
    }
}

extern "C" void kernel_launch(void* const* d_in, const int* in_sizes, int n_in, void* d_out, int out_size, void* d_ws, size_t ws_size, hipStream_t stream) {
    static int grid = 0;
    if (grid == 0) {
        if (n_in != 22 || ws_size < WS_END) { fprintf(stderr, "kernel_launch: unexpected n_in %d / ws %zu\n", n_in, ws_size); grid = -1; return; }
        int dev = 0, cus = 0, per_cu = 0;
        hipGetDevice(&dev); hipDeviceGetAttribute(&cus, hipDeviceAttributeMultiprocessorCount, dev);
        if (hipFuncSetAttribute((const void*)fwd, hipFuncAttributeMaxDynamicSharedMemorySize, LDS_BYTES) != hipSuccess) { fprintf(stderr, "kernel_launch: hipFuncSetAttribute failed\n"); grid = -1; return; }
        if (hipOccupancyMaxActiveBlocksPerMultiprocessor(&per_cu, (const void*)fwd, 512, LDS_BYTES) != hipSuccess || per_cu < 1) { fprintf(stderr, "kernel_launch: occupancy query gave %d\n", per_cu); per_cu = 1; }
        (void)hipGetLastError();
        grid = cus * 1;
    }
    if (grid < 0) return;
    Args a{};
    for (int i = 0; i < 22; ++i) a.in[i] = (const float*)d_in[i];
    a.out = (float*)d_out; a.ws = (unsigned char*)d_ws;
#if N_LAUNCH_MODE == 1
    a.ph_lo = 0; a.ph_hi = NPH;
    void* args[] = {&a};
    hipError_t e = hipLaunchCooperativeKernel((const void*)fwd, dim3(grid), dim3(512), args, LDS_BYTES, stream);
    if (e != hipSuccess) fprintf(stderr, "cooperative launch failed: %s (grid %d)\n", hipGetErrorString(e), grid);
#else
    for (int ph = 0; ph < NPH; ++ph) { a.ph_lo = ph; a.ph_hi = ph + 1; hipLaunchKernelGGL(fwd, dim3(grid), dim3(512), LDS_BYTES, stream, a); }
#endif
}
```
